# Optimizing an MI355X kernel written in HIP

```python
import math
import jax, jax.numpy as jnp
from jax import lax
import numpy as np

D_MODEL = 2048
BATCH = 4
SEQ = 4096
DEPTH = 2

N_META = 16
LRU_WIDTH = D_MODEL // 2
LRU_BLOCKS = 8
LRU_BLOCK_W = LRU_WIDTH // LRU_BLOCKS
CONV_W = 4
LRU_C = 8.0
DA_HEADS = 8
DA_HEAD_DIM = 64
DA_V_DIM = 2 * DA_HEAD_DIM
DA_WIDTH = DA_HEADS * DA_V_DIM
QK_WIDTH = DA_HEADS * 2 * DA_HEAD_DIM
Q_BLOCK = 128
S5_WIDTH = D_MODEL // 2
S5_GROUP = 16
S5_GROUPS = S5_WIDTH // S5_GROUP
S5_STATE = 64
S5_DT_MIN = 1e-3
S5_DT_MAX = 1e-1
REL_BUCKETS = 32
REL_MAX_DIST = 128
N_BRANCH = 3
IN_SIZES = (LRU_WIDTH, LRU_WIDTH, QK_WIDTH, QK_WIDTH, DA_WIDTH, S5_WIDTH, N_BRANCH * D_MODEL)
N_IN = sum(IN_SIZES)
IN_SPLITS = tuple(int(v) for v in np.cumsum(IN_SIZES)[:-1])
D_FF = ((-(-(8 * D_MODEL) // 3) + 255) // 256) * 256

kernel_name = "hybrid_rglru_diffattn_s5_block"


def rms_norm(x, w, eps=1e-6):
    xf = x.astype(jnp.float32)
    xf = xf * lax.rsqrt(jnp.mean(xf * xf, axis=-1, keepdims=True) + eps)
    return (xf * w.astype(jnp.float32)).astype(x.dtype)


def _lin_combine(e1, e2):
    a1, b1 = e1
    a2, b2 = e2
    return a1 * a2, a2 * b1 + b2


def _complex_lin_combine(e1, e2):
    ar1, ai1, br1, bi1 = e1
    ar2, ai2, br2, bi2 = e2
    ar = ar2 * ar1 - ai2 * ai1
    ai = ar2 * ai1 + ai2 * ar1
    br = ar2 * br1 - ai2 * bi1 + br2
    bi = ar2 * bi1 + ai2 * br1 + bi2
    return ar, ai, br, bi


def causal_conv(x, w, b):
    y = lax.conv_general_dilated(
        x, w[:, None, :].astype(x.dtype), window_strides=(1,), padding=[(CONV_W - 1, 0)],
        dimension_numbers=("NWC", "WIO", "NWC"), feature_group_count=x.shape[-1])
    return y + b


def rg_lru_branch(gate_in, x_in, conv_w, conv_b, w_a, b_a, w_x, b_x, lam):
    B, T, _ = x_in.shape
    xc = causal_conv(x_in, conv_w, conv_b)
    xb = xc.reshape(B, T, LRU_BLOCKS, LRU_BLOCK_W)
    r = jax.nn.sigmoid(jnp.einsum("bthi,hij->bthj", xb, w_a).reshape(B, T, LRU_WIDTH) + b_a)
    i = jax.nn.sigmoid(jnp.einsum("bthi,hij->bthj", xb, w_x).reshape(B, T, LRU_WIDTH) + b_x)
    log_a = LRU_C * r.astype(jnp.float32) * jax.nn.log_sigmoid(lam.astype(jnp.float32))
    a = jnp.exp(log_a)
    b = jnp.sqrt(-jnp.expm1(2.0 * log_a)) * (i * xc).astype(jnp.float32)
    _, h = lax.associative_scan(_lin_combine, (a, b), axis=1)
    return h.astype(x_in.dtype) * jax.nn.gelu(gate_in)


def t5_bucket(q_pos, k_pos):
    n = jnp.maximum(q_pos[:, None] - k_pos[None, :], 0)
    max_exact = REL_BUCKETS // 2
    nf = jnp.maximum(n, 1).astype(jnp.float32)
    large = max_exact + (jnp.log(nf / max_exact) / math.log(REL_MAX_DIST / max_exact)
                         * (REL_BUCKETS - max_exact)).astype(jnp.int32)
    large = jnp.minimum(large, REL_BUCKETS - 1)
    return jnp.where(n < max_exact, n, large)


def diff_attention(q, k, v, rel_bias, lam, sub_w, lam_init):
    B, T = q.shape[0], q.shape[1]
    k_pos = jnp.arange(T)
    scale = DA_HEAD_DIM ** -0.5

    def block(q_blk, q_pos):
        s = jnp.einsum("bqhcd,bkhcd->bhcqk", q_blk, k).astype(jnp.float32) * scale
        bias = rel_bias[t5_bucket(q_pos, k_pos)].astype(jnp.float32)
        s = s + jnp.transpose(bias, (2, 0, 1))[None, :, None]
        s = jnp.where(k_pos[None, :] <= q_pos[:, None], s, -jnp.inf)
        p = jax.nn.softmax(s, axis=-1)
        w = p[:, :, 0] - lam * p[:, :, 1]
        return jnp.einsum("bhqk,bkhd->bqhd", w.astype(v.dtype), v)

    out_meta = block(q[:, :N_META], jnp.arange(N_META))
    nb = (T - N_META) // Q_BLOCK
    qb = q[:, N_META:].reshape(B, nb, Q_BLOCK, DA_HEADS, 2, DA_HEAD_DIM).transpose(1, 0, 2, 3, 4, 5)
    pb = (N_META + jnp.arange(nb * Q_BLOCK)).reshape(nb, Q_BLOCK)
    out_real = lax.map(lambda a: block(a[0], a[1]), (qb, pb))
    out_real = out_real.transpose(1, 0, 2, 3, 4).reshape(B, nb * Q_BLOCK, DA_HEADS, DA_V_DIM)
    o = jnp.concatenate([out_meta, out_real], axis=1)
    o = rms_norm(o, sub_w, eps=1e-5) * (1.0 - lam_init)
    return o.reshape(B, T, DA_WIDTH)


def s5_branch(u, lam_re, lam_im, b_re, b_im, c_re, c_im, d, log_step, w_glu, b_glu):
    B, T, _ = u.shape
    f32 = jnp.float32
    uf = u.astype(f32).reshape(B, T, S5_GROUPS, S5_GROUP)
    lr, li = lam_re.astype(f32), lam_im.astype(f32)
    step = jnp.exp(log_step.astype(f32))[:, None]
    mag = jnp.exp(lr * step)
    ab_re, ab_im = mag * jnp.cos(li * step), mag * jnp.sin(li * step)
    den = lr * lr + li * li
    coef_re = ((ab_re - 1.0) * lr + ab_im * li) / den
    coef_im = (ab_im * lr - (ab_re - 1.0) * li) / den
    br, bi = b_re.astype(f32), b_im.astype(f32)
    bb_re = coef_re[..., None] * br - coef_im[..., None] * bi
    bb_im = coef_re[..., None] * bi + coef_im[..., None] * br
    bu_re = jnp.einsum("gpc,btgc->btgp", bb_re, uf)
    bu_im = jnp.einsum("gpc,btgc->btgp", bb_im, uf)
    a_re = jnp.broadcast_to(ab_re[None, None], (1, T, S5_GROUPS, S5_STATE))
    a_im = jnp.broadcast_to(ab_im[None, None], (1, T, S5_GROUPS, S5_STATE))
    _, _, h_re, h_im = lax.associative_scan(_complex_lin_combine, (a_re, a_im, bu_re, bu_im), axis=1)
    y = (jnp.einsum("gcp,btgp->btgc", c_re.astype(f32), h_re)
         - jnp.einsum("gcp,btgp->btgc", c_im.astype(f32), h_im))
    y = y.reshape(B, T, S5_WIDTH) + d.astype(f32) * u.astype(f32)
    y = jax.nn.gelu(y).astype(u.dtype)
    return y * jax.nn.sigmoid(y @ w_glu + b_glu)


def hybrid_mixer(h, lam_init, rel_bias, w_in, conv_w, conv_b, lru_w_a, lru_b_a, lru_w_x, lru_b_x,
                 lru_lambda, da_lambda, da_subln, s5_lam_re, s5_lam_im, s5_b_re, s5_b_im,
                 s5_c_re, s5_c_im, s5_d, s5_log_step, s5_w_glu, s5_b_glu, b_gate, w_branch, w_out):
    B, T, _ = h.shape
    proj = h @ w_in
    a_gate, a_x, q, k, v, s5_u, g = jnp.split(proj, IN_SPLITS, axis=-1)
    y_a = rg_lru_branch(a_gate, a_x, conv_w, conv_b, lru_w_a, lru_b_a, lru_w_x, lru_b_x, lru_lambda)
    lf = da_lambda.astype(jnp.float32)
    lam = jnp.exp(jnp.sum(lf[0] * lf[1])) - jnp.exp(jnp.sum(lf[2] * lf[3])) + lam_init
    y_b = diff_attention(q.reshape(B, T, DA_HEADS, 2, DA_HEAD_DIM),
                         k.reshape(B, T, DA_HEADS, 2, DA_HEAD_DIM),
                         v.reshape(B, T, DA_HEADS, DA_V_DIM), rel_bias, lam, da_subln, lam_init)
    y_c = s5_branch(s5_u, s5_lam_re, s5_lam_im, s5_b_re, s5_b_im, s5_c_re, s5_c_im, s5_d,
                    s5_log_step, s5_w_glu, s5_b_glu)
    gates = jax.nn.sigmoid(g.reshape(B, T, N_BRANCH, D_MODEL) + b_gate)
    merged = (gates[:, :, 0] * (y_a @ w_branch[0])
              + gates[:, :, 1] * (y_b @ w_branch[1])
              + gates[:, :, 2] * (y_c @ w_branch[2]))
    return merged @ w_out


def swiglu(h, w_ffn_in, w_ffn_out):
    gu = h @ w_ffn_in
    gate, up = gu[..., :D_FF], gu[..., D_FF:]
    return (jax.nn.silu(gate) * up) @ w_ffn_out


def setup_inputs(seed: int = 0) -> dict:
    key = jax.random.key(seed)
    ks = jax.random.split(key, 32)
    f32 = jnp.float32

    def nrm(k, shape, scale):
        return scale * jax.random.normal(k, shape, f32)

    x = nrm(ks[0], (BATCH, SEQ, D_MODEL), 1.0)
    meta = nrm(ks[1], (N_META, D_MODEL), 1.0)
    rel_bias = nrm(ks[2], (REL_BUCKETS, DA_HEADS), 0.5)
    norm_w = 1.0 + nrm(ks[3], (DEPTH, 4, D_MODEL), 0.05)
    w_in = nrm(ks[4], (DEPTH, D_MODEL, N_IN), D_MODEL ** -0.5)
    conv_w = nrm(ks[5], (DEPTH, CONV_W, LRU_WIDTH), CONV_W ** -0.5)
    conv_b = nrm(ks[6], (DEPTH, LRU_WIDTH), 0.02)
    lru_w_a = nrm(ks[7], (DEPTH, LRU_BLOCKS, LRU_BLOCK_W, LRU_BLOCK_W), LRU_BLOCK_W ** -0.5)
    lru_b_a = nrm(ks[8], (DEPTH, LRU_WIDTH), 0.02)
    lru_w_x = nrm(ks[9], (DEPTH, LRU_BLOCKS, LRU_BLOCK_W, LRU_BLOCK_W), LRU_BLOCK_W ** -0.5)
    lru_b_x = nrm(ks[10], (DEPTH, LRU_WIDTH), 0.02)
    a8 = jax.random.uniform(ks[11], (DEPTH, LRU_WIDTH), f32, 0.9, 0.999)
    s = a8 ** (1.0 / LRU_C)
    lru_lambda = jnp.log(s) - jnp.log1p(-s)
    da_lambda = nrm(ks[12], (DEPTH, 4, DA_HEAD_DIM), 0.1)
    da_subln = 1.0 + nrm(ks[13], (DEPTH, DA_V_DIM), 0.05)
    s5_lam_re = -0.5 + nrm(ks[14], (DEPTH, S5_GROUPS, S5_STATE), 0.01)
    s5_lam_im = jnp.broadcast_to(math.pi * jnp.arange(S5_STATE, dtype=f32), (DEPTH, S5_GROUPS, S5_STATE))
    s5_b_re = nrm(ks[15], (DEPTH, S5_GROUPS, S5_STATE, S5_GROUP), (2 * S5_GROUP) ** -0.5)
    s5_b_im = nrm(ks[16], (DEPTH, S5_GROUPS, S5_STATE, S5_GROUP), (2 * S5_GROUP) ** -0.5)
    s5_c_re = nrm(ks[17], (DEPTH, S5_GROUPS, S5_GROUP, S5_STATE), S5_STATE ** -0.5)
    s5_c_im = nrm(ks[18], (DEPTH, S5_GROUPS, S5_GROUP, S5_STATE), S5_STATE ** -0.5)
    s5_d = nrm(ks[19], (DEPTH, S5_WIDTH), 1.0)
    s5_log_step = jax.random.uniform(ks[20], (DEPTH, S5_GROUPS), f32,
                                     math.log(S5_DT_MIN), math.log(S5_DT_MAX))
    s5_w_glu = nrm(ks[21], (DEPTH, S5_WIDTH, S5_WIDTH), S5_WIDTH ** -0.5)
    s5_b_glu = nrm(ks[22], (DEPTH, S5_WIDTH), 0.02)
    b_gate = nrm(ks[23], (DEPTH, N_BRANCH, D_MODEL), 0.02)
    w_branch = nrm(ks[24], (DEPTH, N_BRANCH, LRU_WIDTH, D_MODEL), LRU_WIDTH ** -0.5)
    w_out = nrm(ks[25], (DEPTH, D_MODEL, D_MODEL), D_MODEL ** -0.5)
    w_ffn_in = nrm(ks[26], (DEPTH, D_MODEL, 2 * D_FF), D_MODEL ** -0.5)
    w_ffn_out = nrm(ks[27], (DEPTH, D_FF, D_MODEL), D_FF ** -0.5)
    return {"x": x, "meta": meta, "rel_bias": rel_bias, "norm_w": norm_w, "w_in": w_in,
            "conv_w": conv_w, "conv_b": conv_b, "lru_w_a": lru_w_a, "lru_b_a": lru_b_a,
            "lru_w_x": lru_w_x, "lru_b_x": lru_b_x, "lru_lambda": lru_lambda,
            "da_lambda": da_lambda, "da_subln": da_subln, "s5_lam_re": s5_lam_re,
            "s5_lam_im": s5_lam_im, "s5_b_re": s5_b_re, "s5_b_im": s5_b_im, "s5_c_re": s5_c_re,
            "s5_c_im": s5_c_im, "s5_d": s5_d, "s5_log_step": s5_log_step, "s5_w_glu": s5_w_glu,
            "s5_b_glu": s5_b_glu, "b_gate": b_gate, "w_branch": w_branch, "w_out": w_out,
            "w_ffn_in": w_ffn_in, "w_ffn_out": w_ffn_out}


def reference(x, meta, rel_bias, norm_w, w_in, conv_w, conv_b, lru_w_a, lru_b_a, lru_w_x, lru_b_x,
              lru_lambda, da_lambda, da_subln, s5_lam_re, s5_lam_im, s5_b_re, s5_b_im, s5_c_re,
              s5_c_im, s5_d, s5_log_step, s5_w_glu, s5_b_glu, b_gate, w_branch, w_out,
              w_ffn_in, w_ffn_out):
    B = x.shape[0]
    xs = jnp.concatenate([jnp.broadcast_to(meta.astype(x.dtype)[None], (B, N_META, D_MODEL)), x], axis=1)
    for l in range(DEPTH):
        lam_init = 0.8 - 0.6 * math.exp(-0.3 * l)
        h = rms_norm(xs, norm_w[l, 0])
        mix = hybrid_mixer(h, lam_init, rel_bias, w_in[l], conv_w[l], conv_b[l], lru_w_a[l], lru_b_a[l],
                           lru_w_x[l], lru_b_x[l], lru_lambda[l], da_lambda[l], da_subln[l],
                           s5_lam_re[l], s5_lam_im[l], s5_b_re[l], s5_b_im[l], s5_c_re[l], s5_c_im[l],
                           s5_d[l], s5_log_step[l], s5_w_glu[l], s5_b_glu[l], b_gate[l], w_branch[l],
                           w_out[l])
        xs = xs + rms_norm(mix, norm_w[l, 1])
        h = rms_norm(xs, norm_w[l, 2])
        xs = xs + rms_norm(swiglu(h, w_ffn_in[l], w_ffn_out[l]), norm_w[l, 3])
    return xs[:, N_META:]
```

```cpp
#include <hip/hip_runtime.h>
#include <hip/hip_cooperative_groups.h>
#include <cstdio>
#include <cstdint>
namespace cg = cooperative_groups;

#define LAS __attribute__((address_space(3)))
typedef unsigned short bf16_t;
typedef short bf16x8 __attribute__((ext_vector_type(8)));
typedef short bf16x4 __attribute__((ext_vector_type(4)));
typedef float f32x4 __attribute__((ext_vector_type(4)));
typedef float f32x2 __attribute__((ext_vector_type(2)));
typedef unsigned u32x4 __attribute__((ext_vector_type(4)));
typedef unsigned u32x2 __attribute__((ext_vector_type(2)));

constexpr int NB = 4, SEQ = 4096, PADT = 48, TP = 4160, MP = NB * TP;
constexpr int D = 2048, DFF = 5632, LDP = 5120, NGATE = 6144;
constexpr int C_AG = 0, C_AX = 1024, C_Q = 2048, C_K = 3072, C_V = 4096;
constexpr int NCH32 = 130, XROWS = 768, XLD = 640;
constexpr int NCH64 = 65;
constexpr float LOG2E = 1.4426950408889634f;

constexpr size_t MiB = 1u << 20;
constexpr size_t WS_W = 0;
constexpr size_t W_IN = 0, W_BR = 48 * MiB, W_OUT = 60 * MiB, W_GLU = 68 * MiB, W_LRU = 70 * MiB;
constexpr size_t W_F1 = 0, W_F2 = 44 * MiB;
constexpr size_t WS_H = 72 * MiB;
constexpr size_t WS_P5 = 137 * MiB;
constexpr size_t WS_GT = 300 * MiB;
constexpr size_t WS_XC = 495 * MiB;
constexpr size_t WS_VT = 528 * MiB;
constexpr size_t WS_XH = 561 * MiB;
constexpr size_t WS_SB = 621 * MiB;
constexpr size_t WS_TP = 645 * MiB;
constexpr size_t WS_W1 = 685 * MiB;
constexpr size_t WS_AGG = 694 * MiB;
constexpr size_t WS_LSG = 697 * MiB;
constexpr size_t WS_BAR = 697 * MiB + 65536;
constexpr size_t WS_XS = 698 * MiB;
constexpr size_t WS_END = 763 * MiB;

struct Params { const float* in[29]; float* out; unsigned char* ws; };
enum { I_X = 0, I_META, I_RELB, I_NORMW, I_WIN, I_CONVW, I_CONVB, I_LWA, I_LBA, I_LWX, I_LBX, I_LLAM, I_DALAM, I_DASUB, I_S5LR, I_S5LI,
       I_S5BR, I_S5BI, I_S5CR, I_S5CI, I_S5D, I_S5LS, I_S5WG, I_S5BG, I_BGATE, I_WBR, I_WOUT, I_WF1, I_WF2 };

__device__ __forceinline__ int opaque_zero() { int z = 0; asm volatile("" : "+v"(z)); return __builtin_amdgcn_readfirstlane(z); }
__device__ __forceinline__ unsigned char* opaque_ptr(unsigned char* p) { const unsigned long long u = (unsigned long long)p; int lo = (int)(unsigned)u, hi = (int)(unsigned)(u >> 32);
    asm volatile("" : "+v"(lo), "+v"(hi)); lo = __builtin_amdgcn_readfirstlane(lo); hi = __builtin_amdgcn_readfirstlane(hi);
    return (unsigned char*)(__attribute__((address_space(1))) unsigned char*)(((unsigned long long)(unsigned)hi << 32) | (unsigned)lo); }
__device__ __forceinline__ int opaque_tid() { int t = threadIdx.x; asm volatile("" : "+v"(t)); return t; }
__device__ __forceinline__ unsigned cvt_pk_bf16(float lo, float hi) { unsigned r; asm volatile("v_cvt_pk_bf16_f32 %0, %1, %2" : "=v"(r) : "v"(lo), "v"(hi)); return r; }
__device__ __forceinline__ float bf_lo(unsigned w) { return __uint_as_float(w << 16); }
__device__ __forceinline__ float bf_hi(unsigned w) { return __uint_as_float(w & 0xffff0000u); }
__device__ __forceinline__ float bf2f(bf16_t v) { return __uint_as_float(((unsigned)v) << 16); }
__device__ __forceinline__ float sigmoidf_(float x) { return __builtin_amdgcn_rcpf(1.0f + __builtin_amdgcn_exp2f(-1.4426950408889634f * x)); }
__device__ __forceinline__ float gelu_tanh(float x) { const float u = 1.5957691216057308f * (x + 0.044715f * x * x * x); return x * sigmoidf_(u); }
__device__ __forceinline__ float wave_sum(float v) {
    v += __builtin_bit_cast(float, __builtin_amdgcn_update_dpp(0, __builtin_bit_cast(int, v), 0xB1, 0xF, 0xF, true));
    v += __builtin_bit_cast(float, __builtin_amdgcn_update_dpp(0, __builtin_bit_cast(int, v), 0x4E, 0xF, 0xF, true));
    v += __builtin_bit_cast(float, __builtin_amdgcn_update_dpp(0, __builtin_bit_cast(int, v), 0x124, 0xF, 0xF, true));
    v += __builtin_bit_cast(float, __builtin_amdgcn_update_dpp(0, __builtin_bit_cast(int, v), 0x128, 0xF, 0xF, true));
    unsigned a = __float_as_uint(v); auto r = __builtin_amdgcn_permlane16_swap(a, a, false, false); v = __uint_as_float(r[0]) + __uint_as_float(r[1]);
    a = __float_as_uint(v); auto r2 = __builtin_amdgcn_permlane32_swap(a, a, false, false); return __uint_as_float(r2[0]) + __uint_as_float(r2[1]);
}
__device__ __forceinline__ float* xs_row(float* out, float* metab, int m) {
    const int b = m / TP, tp = m - b * TP;
    if (tp < PADT) return nullptr;
    if (tp < 64) return metab + (size_t)(b * 16 + tp - PADT) * D;
    return out + ((size_t)b * SEQ + (tp - 64)) * D;
}

namespace pg8 {
constexpr int BM = 256, BK = 64, HALF = 128, HTB = HALF * BK * 2, STAGE_BYTES = 8 * HTB, NXCD = 8, WGM = 8;
__device__ __forceinline__ int lds_byte(int r, int c) { const int st = (r >> 4) * 2 + (c >> 5), rr = r & 15, cc = c & 31, ob = rr * 64 + cc * 2; return st * 1024 + (ob ^ (((ob >> 9) & 1) << 5)); }
__device__ __forceinline__ void stage_rc(int b, int& R, int& C) { const int st = b / 1024, sb = b % 1024, swz = sb ^ (((sb >> 9) & 1) << 5); R = (st >> 1) * 16 + swz / 64; C = (st & 1) * 32 + (swz % 64) / 2; }
__device__ __forceinline__ int perm32(int rho) { const int n = rho >> 4, i = rho & 15; return 8 * (i >> 2) + 4 * n + (i & 3); }

struct Unit { const char* A; const char* B; int pm, pn, aux, nt; };

__device__ __forceinline__ void dense_tile(int L, int nM, int nN, int& pm, int& pn) {
    const int nwg = nM * nN; int wgid = L;
    { const int q = nwg / NXCD, r = nwg % NXCD, xcd = wgid % NXCD, off = wgid / NXCD; wgid = (xcd < r ? xcd * (q + 1) : r * (q + 1) + (xcd - r) * q) + off; }
    const int nig = WGM * nN, gid = wgid / nig, fm = gid * WGM, gsz = (nM - fm) < WGM ? (nM - fm) : WGM;
    pm = fm + ((wgid % nig) % gsz); pn = (wgid % nig) / gsz;
}
struct DenseOrder {
    const bf16_t* A; const bf16_t* Bt; int lda, ldb, nM, nN, G, c, ntk;
    __device__ __forceinline__ bool next(int i, Unit& u) const {
        const int L = i * G + c; if (L >= nM * nN) return false;
        int pm, pn; dense_tile(L, nM, nN, pm, pn);
        u.pm = pm; u.pn = pn; u.aux = 0; u.nt = ntk;
        u.A = (const char*)(A + (size_t)pm * 256 * lda); u.B = (const char*)(Bt + (size_t)pn * 256 * ldb); return true;
    }
};
struct SplitOrder {
    const bf16_t* A; const bf16_t* Bt; int lda, ldb, nM, nN, G, c, ntk, pieces, nt_piece;
    __device__ __forceinline__ bool next(int i, Unit& u) const {
        const int nfull = (nM - 1) * nN; const int L = i * G + c; int pm, pn, pc = 0, full = 1;
        if (L < nfull) dense_tile(L, nM - 1, nN, pm, pn);
        else { const int s_ = L - nfull; if (s_ >= nN * pieces) return false; pn = s_ / pieces; pc = s_ - pn * pieces; pm = nM - 1; full = 0; }
        u.pm = pm; u.pn = pn; u.aux = full ? 0 : 1 + pc; u.nt = full ? ntk : nt_piece;
        u.A = (const char*)(A + (size_t)pm * 256 * lda + (size_t)pc * nt_piece * 64); u.B = (const char*)(Bt + (size_t)pn * 256 * ldb + (size_t)pc * nt_piece * 64); return true;
    }
};
struct BranchOrder {
    const bf16_t* A0; const bf16_t* Bt; int lda, ldb, nM, nN, G, c, ntk, pieces;
    __device__ __forceinline__ bool next(int i, Unit& u) const {
        const int nfull = (nM - 1) * nN, rounds = nfull / G;
        int pm, pn, br, pc = 0;
        if (i < 3 * rounds) { const int r = i / 3; br = i - 3 * r; dense_tile(r * G + c, nM - 1, nN, pm, pn); u.nt = ntk; u.aux = br; }
        else { const int s_ = (i - 3 * rounds) * G + c; if (s_ >= nN * 3 * pieces) return false;
            pn = s_ / (3 * pieces); const int rem = s_ - pn * 3 * pieces; br = rem / pieces; pc = rem - br * pieces; pm = nM - 1; u.nt = ntk / pieces; u.aux = br | ((1 + pc) << 2); }
        u.pm = pm; u.pn = pn;
        const int acol = br == 0 ? C_AG : (br == 1 ? C_Q : C_K);
        u.A = (const char*)(A0 + (size_t)pm * 256 * lda + acol + (size_t)pc * (ntk / pieces) * 64);
        u.B = (const char*)(Bt + (size_t)br * 2048 * 1024 + (size_t)pn * 256 * ldb + (size_t)pc * (ntk / pieces) * 64); return true;
    }
};
struct GroupOrder {
    const bf16_t* A; const bf16_t* Bt; int lda, ldb, nM, nN, ngroups, a_gstride_rows, b_gstride_rows, a_gcol, G, c, ntk;
    __device__ __forceinline__ bool next(int i, Unit& u) const {
        const int L = i * G + c; const int per = nM * nN; if (L >= per * ngroups) return false;
        const int g = L / per, r = L - g * per; const int pm = r / nN, pn = r - pm * nN;
        u.pm = pm; u.pn = pn; u.aux = g; u.nt = ntk;
        u.A = (const char*)(A + ((size_t)g * a_gstride_rows + (size_t)pm * 256) * lda + (size_t)g * a_gcol);
        u.B = (const char*)(Bt + ((size_t)g * b_gstride_rows + (size_t)pn * 256) * ldb); return true;
    }
};

template <class Epi, class Sched>
__device__ __forceinline__ void gemm_phase(LAS unsigned char* lds, const int lda, const int ldb, const Sched& S, const Epi& E) {
    int tid_ = threadIdx.x; asm volatile("" : "+v"(tid_));
    const int tid = tid_, wid = __builtin_amdgcn_readfirstlane(tid >> 6), lane = tid & 63, wr = wid >> 2, wc = wid & 3, fr = lane & 15, fq = lane >> 4;
    unsigned voffA[2], voffB[2];
#pragma unroll
    for (int i = 0; i < 2; ++i) { int R, C; stage_rc(tid * 16 + i * 8192, R, C); const int Rb = Epi::PERM ? ((R & ~31) + perm32(R & 31)) : R;
        voffA[i] = (unsigned)(R * lda + C) * 2u; voffB[i] = (unsigned)(Rb * ldb + C) * 2u; }
    const size_t kstep = (size_t)(BK * 2);
    const size_t hstepA = (size_t)HALF * lda * 2, hstepB = (size_t)HALF * ldb * 2;
    const unsigned ldsw = (unsigned)wid * 1024u;
    const int aoff = lds_byte(wr * 64 + fr, fq * 8), boff = lds_byte(wc * 32 + fr, fq * 8);
#define PG8_SA(b, h) (((b) * 2 + (h)) * HTB)
#define PG8_SB(b, h) ((4 + (b) * 2 + (h)) * HTB)
#define PG8_STAGE(bufoff, gbase, voff) do { _Pragma("unroll") for (int _i = 0; _i < 2; ++_i) \
        __builtin_amdgcn_global_load_lds((const unsigned*)((const char*)(gbase) + (voff)[_i]), (LAS unsigned*)(lds + (bufoff) + ldsw + _i * 8192), 16, 0, 0); } while (0)
#define PG8_LDA(dst, b, h) do { _Pragma("unroll") for (int m = 0; m < 4; ++m) _Pragma("unroll") for (int k = 0; k < 2; ++k) dst[m][k] = *(const LAS bf16x8*)(lds + PG8_SA(b, h) + aoff + m * 2048 + k * 1024); } while (0)
#define PG8_LDB(dst, b, h) do { _Pragma("unroll") for (int n = 0; n < 2; ++n) _Pragma("unroll") for (int k = 0; k < 2; ++k) dst[n][k] = *(const LAS bf16x8*)(lds + PG8_SB(b, h) + boff + n * 2048 + k * 1024); } while (0)
#define PG8_MMA(ai, bj, At, Bt) do { __builtin_amdgcn_s_setprio(1); _Pragma("unroll") for (int m = 0; m < 4; ++m) _Pragma("unroll") for (int n = 0; n < 2; ++n) _Pragma("unroll") for (int k = 0; k < 2; ++k) \
        acc[ai][bj][m][n] = __builtin_amdgcn_mfma_f32_16x16x32_bf16(Bt[n][k], At[m][k], acc[ai][bj][m][n], 0, 0, 0); __builtin_amdgcn_s_setprio(0); } while (0)
#define PG8_WAIT_V(n) asm volatile("s_waitcnt vmcnt(" #n ")" ::: "memory")
#define PG8_WAIT_L(n) asm volatile("s_waitcnt lgkmcnt(" #n ")" ::: "memory")
#define PG8_BAR __builtin_amdgcn_s_barrier()
#define PG8_SCHED __builtin_amdgcn_sched_barrier(0)
    Unit cur, nxt; int ui = 0;
    if (!S.next(0, cur)) return;
    f32x4 acc[2][2][4][2];
#pragma unroll
    for (int a = 0; a < 2; ++a)
#pragma unroll
        for (int b = 0; b < 2; ++b)
#pragma unroll
            for (int m = 0; m < 4; ++m)
#pragma unroll
                for (int n = 0; n < 2; ++n) acc[a][b][m][n] = (f32x4){0.f, 0.f, 0.f, 0.f};
    bf16x8 At[4][2], B0[2][2], B1[2][2];
    const char* cA = cur.A; const char* cB = cur.B; asm volatile("" : "+s"(cA), "+s"(cB));
    PG8_STAGE(PG8_SB(0, 0), cB, voffB); PG8_STAGE(PG8_SB(0, 1), cB + hstepB, voffB); PG8_STAGE(PG8_SA(0, 0), cA, voffA); PG8_STAGE(PG8_SA(0, 1), cA + hstepA, voffA);
    if (wr == 1) PG8_BAR;
    PG8_WAIT_V(2); PG8_BAR;
    PG8_STAGE(PG8_SB(1, 0), cB + kstep, voffB); PG8_STAGE(PG8_SA(1, 0), cA + kstep, voffA); PG8_STAGE(PG8_SB(1, 1), cB + hstepB + kstep, voffB);
    PG8_WAIT_V(6); PG8_BAR;
    for (;;) {
        const bool has_next = S.next(ui + 1, nxt);
        const char* nA = has_next ? nxt.A : cA; const char* nB = has_next ? nxt.B : cB;
        const int nt = cur.nt;
#pragma unroll 1
        for (int t = 0; t < nt; t += 2) {
            const bool last = (t == nt - 2);
            const char* a1 = cA + (size_t)(t + 1) * kstep;
            const char* a2 = last ? nA : cA + (size_t)(t + 2) * kstep; const char* b2 = last ? nB : cB + (size_t)(t + 2) * kstep;
            const char* a3 = a2 + kstep; const char* b3 = b2 + kstep;
            PG8_LDB(B0, 0, 0); PG8_LDB(B1, 0, 1); PG8_SCHED; PG8_LDA(At, 0, 0); PG8_STAGE(PG8_SA(1, 1), a1 + hstepA, voffA);
            PG8_WAIT_V(8); PG8_WAIT_L(0); PG8_BAR; PG8_MMA(0, 0, At, B0); PG8_MMA(0, 1, At, B1); PG8_BAR; PG8_SCHED;
            PG8_LDA(At, 0, 1); PG8_STAGE(PG8_SB(0, 0), b2, voffB); PG8_STAGE(PG8_SB(0, 1), b2 + hstepB, voffB); PG8_STAGE(PG8_SA(0, 0), a2, voffA);
            PG8_WAIT_V(8); PG8_WAIT_L(0); PG8_BAR; PG8_MMA(1, 0, At, B0); PG8_MMA(1, 1, At, B1); PG8_BAR; PG8_SCHED;
            PG8_LDB(B0, 1, 0); PG8_LDB(B1, 1, 1); PG8_SCHED; PG8_LDA(At, 1, 0); PG8_STAGE(PG8_SA(0, 1), a2 + hstepA, voffA);
            PG8_WAIT_V(8); PG8_WAIT_L(0); PG8_BAR; PG8_MMA(0, 0, At, B0); PG8_MMA(0, 1, At, B1); PG8_BAR; PG8_SCHED;
            PG8_LDA(At, 1, 1); PG8_STAGE(PG8_SB(1, 0), b3, voffB); PG8_STAGE(PG8_SB(1, 1), b3 + hstepB, voffB); PG8_STAGE(PG8_SA(1, 0), a3, voffA);
            PG8_WAIT_V(8); PG8_WAIT_L(0); PG8_BAR; PG8_MMA(1, 0, At, B0); PG8_MMA(1, 1, At, B1); PG8_BAR; PG8_SCHED;
        }
        if (wr == 0) PG8_BAR;
        { const int t2 = opaque_tid(); const int w2 = __builtin_amdgcn_readfirstlane(t2 >> 6); E(acc, cur, w2 >> 2, w2 & 3, t2 & 15, (t2 & 63) >> 4); }
        if (!has_next) break;
#pragma unroll
        for (int a = 0; a < 2; ++a)
#pragma unroll
            for (int b = 0; b < 2; ++b)
#pragma unroll
                for (int m = 0; m < 4; ++m)
#pragma unroll
                    for (int n = 0; n < 2; ++n) acc[a][b][m][n] = (f32x4){0.f, 0.f, 0.f, 0.f};
        cur = nxt; cA = nA; cB = nB; ++ui;
        if (wr == 1) PG8_BAR;
    }
    PG8_WAIT_V(0);
    PG8_BAR;
#undef PG8_SA
#undef PG8_SB
#undef PG8_STAGE
#undef PG8_LDA
#undef PG8_LDB
#undef PG8_MMA
#undef PG8_WAIT_V
#undef PG8_WAIT_L
#undef PG8_BAR
#undef PG8_SCHED
}

typedef f32x4 Acc[2][2][4][2];

struct EpiG1 {
    static constexpr bool PERM = true;
    bf16_t* p5; bf16_t* xh; bf16_t* gates; const float* bgate;
    __device__ __forceinline__ void operator()(const Acc& acc, const Unit& u, int wr, int wc, int fr, int fq) const {
        const int row0 = u.pm * 256 + wr * 64 + fr; const int pn = u.pn;
        f32x4 gb[2][2];
#pragma unroll
        for (int bj = 0; bj < 2; ++bj) { const int cg_ = (pn >= 24 ? (pn - 24) * 256 : 0) + bj * 128 + wc * 32 + 8 * fq;
            gb[bj][0] = *(const f32x4*)(bgate + cg_); gb[bj][1] = *(const f32x4*)(bgate + cg_ + 4); }
#pragma unroll
        for (int ai = 0; ai < 2; ++ai)
#pragma unroll
            for (int m = 0; m < 4; ++m) {
                const int row = row0 + ai * 128 + m * 16;
#pragma unroll
                for (int bj = 0; bj < 2; ++bj) {
                    const int colt = bj * 128 + wc * 32 + 8 * fq;
                    f32x4 v0 = acc[ai][bj][m][0], v1 = acc[ai][bj][m][1];
                    bf16_t* dst;
                    if (pn < 20) dst = p5 + (size_t)row * LDP + pn * 256 + colt;
                    else if (pn < 24) {
                        const int cu = (pn - 20) * 256 + colt, g = cu >> 4, c0 = cu & 15;
                        const int b = row / TP, tp = row - b * TP, chunk = tp >> 5, jj = tp & 31;
                        dst = xh + ((size_t)g * XROWS + b * NCH32 + chunk) * XLD + jj * 16 + c0;
                    } else {
                        const int cg_ = (pn - 24) * 256 + colt;
                        unsigned q0 = 0u, q1 = 0u;
#pragma unroll
                        for (int j = 0; j < 4; ++j) { q0 |= (unsigned)(sigmoidf_(v0[j] + gb[bj][0][j]) * 255.0f + 0.5f) << (8 * j); q1 |= (unsigned)(sigmoidf_(v1[j] + gb[bj][1][j]) * 255.0f + 0.5f) << (8 * j); }
                        *(u32x2*)((unsigned char*)gates + (size_t)row * NGATE + cg_) = (u32x2){q0, q1};
                        continue;
                    }
                    u32x4 w; w.x = cvt_pk_bf16(v0[0], v0[1]); w.y = cvt_pk_bf16(v0[2], v0[3]); w.z = cvt_pk_bf16(v1[0], v1[1]); w.w = cvt_pk_bf16(v1[2], v1[3]);
                    *(u32x4*)dst = w;
                }
            }
    }
};
struct EpiLru {
    static constexpr bool PERM = true;
    bf16_t* p5; bf16_t* xc; const float* ba; const float* bx; const float* lsgp;
    __device__ __forceinline__ void operator()(const Acc& acc, const Unit& u, int wr, int wc, int fr, int fq) const {
        const int row0 = u.pm * 256 + wr * 64 + fr; int chb = u.aux * 128 + wc * 32 + 8 * fq; asm volatile("" : "+v"(chb));
#pragma unroll
        for (int n = 0; n < 2; ++n) {
            const int ch0 = chb + 4 * n;
            const f32x4 lsg = *(const f32x4*)(lsgp + ch0), bav = *(const f32x4*)(ba + ch0), bxv = *(const f32x4*)(bx + ch0);
            u32x2 xw[2][4];
#pragma unroll
            for (int ai = 0; ai < 2; ++ai)
#pragma unroll
                for (int m = 0; m < 4; ++m) xw[ai][m] = *(const u32x2*)(xc + (size_t)(row0 + ai * 128 + m * 16) * 1024 + ch0);
#pragma unroll
            for (int ai = 0; ai < 2; ++ai)
#pragma unroll
                for (int m = 0; m < 4; ++m) {
                    const int row = row0 + ai * 128 + m * 16; const int tp = row % TP;
                    const float xv[4] = {bf_lo(xw[ai][m].x), bf_hi(xw[ai][m].x), bf_lo(xw[ai][m].y), bf_hi(xw[ai][m].y)};
                    float la[4], bb[4];
#pragma unroll
                    for (int j = 0; j < 4; ++j) {
                        const float rp = acc[ai][0][m][n][j], ip = acc[ai][1][m][n][j];
                        const float l_ = lsg[j] * sigmoidf_(rp + bav[j]);
                        la[j] = l_;
                        const float t2 = 1.0f - __expf(2.0f * l_);
                        bb[j] = (tp < PADT) ? 0.0f : sqrtf(fmaxf(t2, 0.0f)) * sigmoidf_(ip + bxv[j]) * xv[j];
                    }
                    *(u32x2*)(p5 + (size_t)row * LDP + C_AX + ch0) = (u32x2){cvt_pk_bf16(la[0], la[1]), cvt_pk_bf16(la[2], la[3])};
                    *(u32x2*)(xc + (size_t)row * 1024 + ch0) = (u32x2){cvt_pk_bf16(bb[0], bb[1]), cvt_pk_bf16(bb[2], bb[3])};
                }
            asm volatile("" ::: "memory");
        }
    }
};
struct EpiS5S {
    static constexpr bool PERM = false;
    float* sb;
    __device__ __forceinline__ void operator()(const Acc& acc, const Unit& u, int wr, int wc, int fr, int fq) const {
        const int row0 = u.aux * XROWS + u.pm * 256 + wr * 64 + fr; const int col0 = wc * 32 + 4 * fq;
#pragma unroll
        for (int ai = 0; ai < 2; ++ai)
#pragma unroll
            for (int m = 0; m < 4; ++m) { float* rowp = sb + (size_t)(row0 + ai * 128 + m * 16) * 128 + col0;
#pragma unroll
                for (int n = 0; n < 2; ++n) *(f32x4*)(rowp + n * 16) = acc[ai][0][m][n]; }
    }
};
struct EpiS5Y {
    static constexpr bool PERM = true;
    bf16_t* p5; const bf16_t* xh; const float* dsk;
    __device__ __forceinline__ void operator()(const Acc& acc, const Unit& u, int wr, int wc, int fr, int fq) const {
        const int g = u.aux; const int rr0 = u.pm * 256 + wr * 64 + fr;
        f32x4 dv[2][2];
#pragma unroll
        for (int bj = 0; bj < 2; ++bj) { const int n0 = u.pn * 256 + bj * 128 + wc * 32 + 8 * fq; const int ch = g * 16 + (n0 & 15);
            dv[bj][0] = *(const f32x4*)(dsk + ch); dv[bj][1] = *(const f32x4*)(dsk + ch + 4); }
#pragma unroll
        for (int ai = 0; ai < 2; ++ai) {
            u32x4 uw[4][2];
#pragma unroll
            for (int m = 0; m < 4; ++m)
#pragma unroll
                for (int bj = 0; bj < 2; ++bj) uw[m][bj] = *(const u32x4*)(xh + ((size_t)g * XROWS + rr0 + ai * 128 + m * 16) * XLD + u.pn * 256 + bj * 128 + wc * 32 + 8 * fq);
#pragma unroll
            for (int m = 0; m < 4; ++m) {
                const int rr = rr0 + ai * 128 + m * 16;
                if (rr < NB * NCH32) {
                    const int b = rr / NCH32, chunk = rr - b * NCH32;
#pragma unroll
                    for (int bj = 0; bj < 2; ++bj) {
                        const int n0 = u.pn * 256 + bj * 128 + wc * 32 + 8 * fq; const int i = n0 >> 4, co0 = n0 & 15;
                        const u32x4 w_ = uw[m][bj];
                        const float uv[8] = {bf_lo(w_.x), bf_hi(w_.x), bf_lo(w_.y), bf_hi(w_.y), bf_lo(w_.z), bf_hi(w_.z), bf_lo(w_.w), bf_hi(w_.w)};
                        const int ch = g * 16 + co0; float y[8];
#pragma unroll
                        for (int j = 0; j < 8; ++j) y[j] = gelu_tanh(acc[ai][bj][m][j >> 2][j & 3] + dv[bj][j >> 2][j & 3] * uv[j]);
                        u32x4 w; w.x = cvt_pk_bf16(y[0], y[1]); w.y = cvt_pk_bf16(y[2], y[3]); w.z = cvt_pk_bf16(y[4], y[5]); w.w = cvt_pk_bf16(y[6], y[7]);
                        *(u32x4*)(p5 + ((size_t)b * TP + chunk * 32 + i) * LDP + C_V + ch) = w;
                    }
                }
            }
            asm volatile("" ::: "memory");
        }
    }
};
struct EpiGlu {
    static constexpr bool PERM = true;
    bf16_t* p5; const float* bglu;
    __device__ __forceinline__ void operator()(const Acc& acc, const Unit& u, int wr, int wc, int fr, int fq) const {
        const int row0 = u.pm * 256 + wr * 64 + fr;
#pragma unroll
        for (int bj = 0; bj < 2; ++bj) {
            const int col = u.pn * 256 + bj * 128 + wc * 32 + 8 * fq;
            const f32x4 b0 = *(const f32x4*)(bglu + col), b1 = *(const f32x4*)(bglu + col + 4);
            u32x4 yw[2][4];
#pragma unroll
            for (int ai = 0; ai < 2; ++ai)
#pragma unroll
                for (int m = 0; m < 4; ++m) yw[ai][m] = *(const u32x4*)(p5 + (size_t)(row0 + ai * 128 + m * 16) * LDP + C_V + col);
#pragma unroll
            for (int ai = 0; ai < 2; ++ai)
#pragma unroll
                for (int m = 0; m < 4; ++m) {
                    const int row = row0 + ai * 128 + m * 16; const u32x4 w_ = yw[ai][m];
                    const float yv[8] = {bf_lo(w_.x), bf_hi(w_.x), bf_lo(w_.y), bf_hi(w_.y), bf_lo(w_.z), bf_hi(w_.z), bf_lo(w_.w), bf_hi(w_.w)};
                    float o[8];
#pragma unroll
                    for (int j = 0; j < 8; ++j) o[j] = yv[j] * sigmoidf_(acc[ai][bj][m][j >> 2][j & 3] + (j < 4 ? b0[j & 3] : b1[j & 3]));
                    u32x4 w; w.x = cvt_pk_bf16(o[0], o[1]); w.y = cvt_pk_bf16(o[2], o[3]); w.z = cvt_pk_bf16(o[4], o[5]); w.w = cvt_pk_bf16(o[6], o[7]);
                    *(u32x4*)(p5 + (size_t)row * LDP + C_K + col) = w;
                }
            asm volatile("" ::: "memory");
        }
    }
};
struct EpiG2 {
    static constexpr bool PERM = true;
    const bf16_t* gates; u32x4* scr; bf16_t* merged; float* part; int pieces;
    __device__ __forceinline__ void operator()(const Acc& acc, const Unit& u, int wr, int wc, int fr, int fq) const {
        const int row0 = u.pm * 256 + wr * 64 + fr; const int br = u.aux & 3, pcs = u.aux >> 2;
        unsigned soff = (unsigned)opaque_tid();
        float* pbase = part + (size_t)((u.pn * 3 + br) * pieces + (pcs - 1)) * 65536;
#pragma unroll
        for (int ai = 0; ai < 2; ++ai)
#pragma unroll
            for (int mh = 0; mh < 2; ++mh) {
                u32x2 gw[2][2]; u32x4 ps[2][2];
#pragma unroll
                for (int mm = 0; mm < 2; ++mm)
#pragma unroll
                    for (int bj = 0; bj < 2; ++bj) {
                        const int row = row0 + ai * 128 + (2 * mh + mm) * 16, col = u.pn * 256 + bj * 128 + wc * 32 + 8 * fq;
                        gw[mm][bj] = *(const u32x2*)((const unsigned char*)gates + (size_t)row * NGATE + br * 2048 + col);
                        if (br > 0 && pcs == 0) ps[mm][bj] = scr[soff + (mm * 2 + bj) * 512];
                    }
#pragma unroll
                for (int mm = 0; mm < 2; ++mm)
#pragma unroll
                    for (int bj = 0; bj < 2; ++bj) {
                        const int m = 2 * mh + mm; const int row = row0 + ai * 128 + m * 16; const int colt = bj * 128 + wc * 32 + 8 * fq, col = u.pn * 256 + colt;
                        const u32x2 g_ = gw[mm][bj]; const float k255 = 1.0f / 255.0f;
                        f32x4 v0 = acc[ai][bj][m][0], v1 = acc[ai][bj][m][1];
#pragma unroll
                        for (int j = 0; j < 4; ++j) { v0[j] *= (float)((g_.x >> (8 * j)) & 0xffu) * k255; v1[j] *= (float)((g_.y >> (8 * j)) & 0xffu) * k255; }
                        if (pcs) { float* d = pbase + (size_t)(wr * 64 + fr + ai * 128 + m * 16) * 256 + colt; *(f32x4*)d = v0; *(f32x4*)(d + 4) = v1; }
                        else {
                            if (br > 0) { const u32x4 p_ = ps[mm][bj];
                                v0[0] += bf_lo(p_.x); v0[1] += bf_hi(p_.x); v0[2] += bf_lo(p_.y); v0[3] += bf_hi(p_.y);
                                v1[0] += bf_lo(p_.z); v1[1] += bf_hi(p_.z); v1[2] += bf_lo(p_.w); v1[3] += bf_hi(p_.w); }
                            u32x4 w; w.x = cvt_pk_bf16(v0[0], v0[1]); w.y = cvt_pk_bf16(v0[2], v0[3]); w.z = cvt_pk_bf16(v1[0], v1[1]); w.w = cvt_pk_bf16(v1[2], v1[3]);
                            if (br < 2) scr[soff + (mm * 2 + bj) * 512] = w;
                            else *(u32x4*)(merged + (size_t)row * D + col) = w;
                        }
                    }
                soff += 2048u; asm volatile("" : "+v"(soff) :: "memory");
            }
    }
};
__device__ __forceinline__ void g2_tail_reduce(const float* part, int pieces, bf16_t* merged) {
    const int tid = opaque_tid(); const int pn = (4 * tid) >> 8, cc = (4 * tid) & 255;
    for (int R = blockIdx.x; R < 256; R += gridDim.x) {
        f32x4 a = (f32x4){0.f, 0.f, 0.f, 0.f};
#pragma unroll 12
        for (int k = 0; k < 3 * pieces; ++k) a += *(const f32x4*)(part + (size_t)(pn * 3 * pieces + k) * 65536 + (size_t)R * 256 + cc);
        *(u32x2*)(merged + (size_t)(MP - 256 + R) * D + 4 * tid) = (u32x2){cvt_pk_bf16(a.x, a.y), cvt_pk_bf16(a.z, a.w)};
    }
}
struct EpiMix {
    static constexpr bool PERM = true;
    bf16_t* C; int ldc; float* part; int pieces;
    __device__ __forceinline__ void operator()(const Acc& acc, const Unit& u, int wr, int wc, int fr, int fq) const {
        const int r0 = wr * 64 + fr;
#pragma unroll
        for (int ai = 0; ai < 2; ++ai)
#pragma unroll
            for (int m = 0; m < 4; ++m) { const int r = r0 + ai * 128 + m * 16;
#pragma unroll
                for (int bj = 0; bj < 2; ++bj) { const int colt = bj * 128 + wc * 32 + 8 * fq; const f32x4 v0 = acc[ai][bj][m][0], v1 = acc[ai][bj][m][1];
                    if (u.aux == 0) { u32x4 w; w.x = cvt_pk_bf16(v0[0], v0[1]); w.y = cvt_pk_bf16(v0[2], v0[3]); w.z = cvt_pk_bf16(v1[0], v1[1]); w.w = cvt_pk_bf16(v1[2], v1[3]);
                        *(u32x4*)(C + (size_t)(u.pm * 256 + r) * ldc + u.pn * 256 + colt) = w; }
                    else { float* d = part + (size_t)(u.pn * pieces + (u.aux - 1)) * 65536 + (size_t)r * 256 + colt; *(f32x4*)d = v0; *(f32x4*)(d + 4) = v1; } }
                asm volatile("" ::: "memory"); }
    }
};
struct EpiSwiglu {
    static constexpr bool PERM = true;
    bf16_t* hid;
    __device__ __forceinline__ void operator()(const Acc& acc, const Unit& u, int wr, int wc, int fr, int fq) const {
        const int row0 = u.pm * 256 + wr * 64 + fr; const int col = u.pn * 128 + wc * 32 + 8 * fq;
#pragma unroll
        for (int ai = 0; ai < 2; ++ai)
#pragma unroll
            for (int m = 0; m < 4; ++m) {
                float o[8];
#pragma unroll
                for (int j = 0; j < 8; ++j) { const float g = acc[ai][0][m][j >> 2][j & 3], up = acc[ai][1][m][j >> 2][j & 3]; o[j] = g * sigmoidf_(g) * up; }
                u32x4 w; w.x = cvt_pk_bf16(o[0], o[1]); w.y = cvt_pk_bf16(o[2], o[3]); w.z = cvt_pk_bf16(o[4], o[5]); w.w = cvt_pk_bf16(o[6], o[7]);
                *(u32x4*)(hid + (size_t)(row0 + ai * 128 + m * 16) * DFF + col) = w;
            }
    }
};
}

template <int MAPMODE>
__device__ __forceinline__ void transpose_item(const float* W, int K, int N, bf16_t* WT, int item, int sub, int lane) {
    const int nblk = N / 256, kb = item / nblk, nb = item - kb * nblk, n = 256 * nb + 4 * lane;
    int nn = n;
    if (MAPMODE == 1) { if (nn < DFF) nn = 256 * (nn >> 7) + (nn & 127); else { const int q = nn - DFF; nn = 256 * (q >> 7) + 128 + (q & 127); } }
    {
        const int k0 = 64 * kb + 16 * sub;
        f32x4 r[16];
#pragma unroll
        for (int e = 0; e < 16; ++e) r[e] = *(const f32x4*)(W + (size_t)(k0 + e) * N + n);
#pragma unroll
        for (int j = 0; j < 4; ++j) {
            u32x4 o0, o1;
            o0.x = cvt_pk_bf16(r[0][j], r[1][j]); o0.y = cvt_pk_bf16(r[2][j], r[3][j]); o0.z = cvt_pk_bf16(r[4][j], r[5][j]); o0.w = cvt_pk_bf16(r[6][j], r[7][j]);
            o1.x = cvt_pk_bf16(r[8][j], r[9][j]); o1.y = cvt_pk_bf16(r[10][j], r[11][j]); o1.z = cvt_pk_bf16(r[12][j], r[13][j]); o1.w = cvt_pk_bf16(r[14][j], r[15][j]);
            bf16_t* d = WT + (size_t)(nn + j) * K + k0;
            *(u32x4*)d = o0; *(u32x4*)(d + 8) = o1;
        }
    }
}

__device__ __forceinline__ void s5_gen_task(LAS unsigned char* lds, int g, int qd, const float* lam_re, const float* lam_im, const float* b_re, const float* b_im,
                                            const float* c_re, const float* c_im, const float* log_step, bf16_t* TPm, bf16_t* W1) {
    LAS float* pwr = (LAS float*)lds;
    LAS float* pwi = pwr + 33 * 64;
    LAS float* bbr = pwi + 33 * 64;
    LAS float* bbi = bbr + 1024;
    LAS float* cr = bbi + 1024;
    LAS float* ci = cr + 1024;
    LAS float* Kt = ci + 1024;
    const int tid = opaque_tid();
    __syncthreads();
    {
        const int p = tid & 63, ds = tid >> 6; const float lr = lam_re[g * 64 + p], li = lam_im[g * 64 + p], step = expf(log_step[g]);
        for (int d = ds; d <= 32; d += 8) { const float mag = expf((float)d * lr * step); float s_, c_; sincosf((float)d * li * step, &s_, &c_); pwr[d * 64 + p] = mag * c_; pwi[d * 64 + p] = mag * s_; }
        if (ds == 0) {
            const float mag = expf(lr * step); float s_, c_; sincosf(li * step, &s_, &c_); const float ar = mag * c_, aim = mag * s_;
            const float den = lr * lr + li * li; const float cre = ((ar - 1.0f) * lr + aim * li) / den, cim = (aim * lr - (ar - 1.0f) * li) / den;
            for (int cc = 0; cc < 16; ++cc) { const float br = b_re[((size_t)g * 64 + p) * 16 + cc], bi = b_im[((size_t)g * 64 + p) * 16 + cc];
                bbr[p * 16 + cc] = cre * br - cim * bi; bbi[p * 16 + cc] = cre * bi + cim * br; }
        }
    }
    for (int i = tid; i < 1024; i += 512) { cr[i] = c_re[(size_t)g * 1024 + i]; ci[i] = c_im[(size_t)g * 1024 + i]; }
    __syncthreads();
    for (int e = tid; e < 2048; e += 512) {
        const int d = e >> 6, col = (e >> 4) & 3, co = 4 * qd + col, cin = e & 15; float a = 0.f;
        for (int p = 0; p < 64; ++p) { const float pr = pwr[d * 64 + p], pi = pwi[d * 64 + p], br = bbr[p * 16 + cin], bi = bbi[p * 16 + cin];
            const float er = pr * br - pi * bi, ei = pr * bi + pi * br; a += cr[co * 64 + p] * er - ci[co * 64 + p] * ei; }
        Kt[e] = a;
    }
    __syncthreads();
    bf16_t* tp = TPm + (size_t)g * 512 * XLD;
    for (int q = tid; q < 128 * 80; q += 512) {
        const int nl = q / 80, kc = q - nl * 80, k0 = kc * 8; const int i = nl >> 2, col = nl & 3, co = 4 * qd + col, n = i * 16 + co; float v[8];
        if (k0 < 512) { const int j = k0 >> 4, cin0 = k0 & 15;
#pragma unroll
            for (int e = 0; e < 8; ++e) v[e] = (j <= i) ? Kt[(i - j) * 64 + col * 16 + cin0 + e] : 0.f;
        } else { const int p0 = (k0 - 512) >> 1;
#pragma unroll
            for (int e = 0; e < 4; ++e) { const int p = p0 + e; const float pr = pwr[(i + 1) * 64 + p], pi = pwi[(i + 1) * 64 + p], c_r = cr[co * 64 + p], c_i = ci[co * 64 + p];
                v[2 * e] = c_r * pr - c_i * pi; v[2 * e + 1] = -(c_r * pi + c_i * pr); }
        }
        u32x4 w; w.x = cvt_pk_bf16(v[0], v[1]); w.y = cvt_pk_bf16(v[2], v[3]); w.z = cvt_pk_bf16(v[4], v[5]); w.w = cvt_pk_bf16(v[6], v[7]);
        *(u32x4*)(tp + (size_t)n * XLD + k0) = w;
    }
    bf16_t* w1 = W1 + (size_t)g * 128 * 512;
    for (int q = tid; q < 32 * 64; q += 512) {
        const int n = 32 * qd + (q >> 6), kc = q & 63, k0 = kc * 8; const int p = n >> 1, r = n & 1; const int j = k0 >> 4, cin0 = k0 & 15; float v[8];
        const float pr = pwr[(31 - j) * 64 + p], pi = pwi[(31 - j) * 64 + p];
#pragma unroll
        for (int e = 0; e < 8; ++e) { const float br = bbr[p * 16 + cin0 + e], bi = bbi[p * 16 + cin0 + e]; v[e] = r ? (pr * bi + pi * br) : (pr * br - pi * bi); }
        u32x4 w; w.x = cvt_pk_bf16(v[0], v[1]); w.y = cvt_pk_bf16(v[2], v[3]); w.z = cvt_pk_bf16(v[4], v[5]); w.w = cvt_pk_bf16(v[6], v[7]);
        *(u32x4*)(w1 + (size_t)n * 512 + k0) = w;
    }
    __syncthreads();
}

#define GASF const __attribute__((address_space(1))) float
__device__ __forceinline__ void phase_norm(const Params& P, int mode, const bf16_t* src, const float* w_add, const float* w_norm, bf16_t* hbuf, bf16_t* xsb, const float* part, int pieces) {
    const int tid_ = opaque_tid(); const int lane = tid_ & 63, wave = tid_ >> 6; const int gw = blockIdx.x * 8 + wave, NGW = gridDim.x * 8;
    for (int m = gw; m < MP; m += NGW) {
        const int b = m / TP, tp = m - b * TP;
        u32x2* hrow = (u32x2*)(hbuf + (size_t)m * D) + lane;
        if (tp < PADT) { if (mode != 2) {
#pragma unroll
                for (int j = 0; j < 8; ++j) hrow[64 * j] = (u32x2){0u, 0u}; }
            continue; }
        if (mode == 2 && tp < 64) continue;
        f32x4 v[8];
        if (mode == 0 || mode == 3) {
            GASF* s0 = (tp < 64) ? (GASF*)P.in[I_META] + (size_t)(tp - PADT) * D : (GASF*)P.in[I_X] + ((size_t)b * SEQ + (tp - 64)) * D;
#pragma unroll
            for (int j = 0; j < 8; ++j) v[j] = ((const __attribute__((address_space(1))) f32x4*)s0)[lane + 64 * j];
        } else {
#pragma unroll
            for (int j = 0; j < 8; ++j) { const u32x2 w = ((const u32x2*)(xsb + (size_t)m * D))[lane + 64 * j]; v[j] = (f32x4){bf_lo(w.x), bf_hi(w.x), bf_lo(w.y), bf_hi(w.y)}; }
        }
        if (mode != 0) {
            f32x4 s[8]; float ss = 0.f;
            if (m < MP - 256) {
#pragma unroll
                for (int j = 0; j < 8; ++j) { const u32x2 w = ((const u32x2*)(src + (size_t)m * D))[lane + 64 * j]; s[j] = (f32x4){bf_lo(w.x), bf_hi(w.x), bf_lo(w.y), bf_hi(w.y)}; }
            } else {
#pragma unroll
                for (int j = 0; j < 8; ++j) s[j] = (f32x4){0.f, 0.f, 0.f, 0.f};
#pragma unroll 4
                for (int pc = 0; pc < pieces; ++pc) {
#pragma unroll
                    for (int j = 0; j < 8; ++j) s[j] += ((const f32x4*)(part + ((size_t)(j * pieces + pc) * 256 + (m - (MP - 256))) * 256))[lane];
                }
            }
#pragma unroll
            for (int j = 0; j < 8; ++j) ss += (s[j].x * s[j].x + s[j].y * s[j].y) + (s[j].z * s[j].z + s[j].w * s[j].w);
            const float r = rsqrtf(wave_sum(ss) * (1.0f / D) + 1e-6f);
#pragma unroll
            for (int j = 0; j < 8; ++j) { const f32x4 w = ((const f32x4*)w_add)[lane + 64 * j]; v[j] += s[j] * r * w; }
            if (mode == 2) {
                __attribute__((address_space(1))) f32x4* o = (__attribute__((address_space(1))) f32x4*)((__attribute__((address_space(1))) float*)P.out + ((size_t)b * SEQ + (tp - 64)) * D);
#pragma unroll
                for (int j = 0; j < 8; ++j) o[lane + 64 * j] = v[j];
                continue;
            }
#pragma unroll
            for (int j = 0; j < 8; ++j) ((u32x2*)(xsb + (size_t)m * D))[lane + 64 * j] = (u32x2){cvt_pk_bf16(v[j].x, v[j].y), cvt_pk_bf16(v[j].z, v[j].w)};
        }
        float ss = 0.f;
#pragma unroll
        for (int j = 0; j < 8; ++j) ss += (v[j].x * v[j].x + v[j].y * v[j].y) + (v[j].z * v[j].z + v[j].w * v[j].w);
        const float r = rsqrtf(wave_sum(ss) * (1.0f / D) + 1e-6f);
#pragma unroll
        for (int j = 0; j < 8; ++j) { const f32x4 w = ((const f32x4*)w_norm)[lane + 64 * j]; const f32x4 o = v[j] * r * w;
            hrow[64 * j] = (u32x2){cvt_pk_bf16(o.x, o.y), cvt_pk_bf16(o.z, o.w)}; }
    }
}

__device__ __forceinline__ void phase_prep(LAS unsigned char* lds, const bf16_t* p5, bf16_t* xc, bf16_t* vt, const float* cw, const float* cb) {
    const int tid = opaque_tid(); const int gt = blockIdx.x * 512 + tid, NGT = gridDim.x * 512;
    for (int it = gt; it < MP * 128; it += NGT) {
        const int m = it >> 7, c0 = (it & 127) * 8; float o[8];
#pragma unroll
        for (int j = 0; j < 8; ++j) o[j] = cb[c0 + j];
#pragma unroll
        for (int k = 0; k < 4; ++k) { const int mm = m - 3 + k; if (mm >= 0) {
                const u32x4 a = *(const u32x4*)(p5 + (size_t)mm * LDP + C_AX + c0);
                const float av[8] = {bf_lo(a.x), bf_hi(a.x), bf_lo(a.y), bf_hi(a.y), bf_lo(a.z), bf_hi(a.z), bf_lo(a.w), bf_hi(a.w)};
#pragma unroll
                for (int j = 0; j < 8; ++j) o[j] += cw[k * 1024 + c0 + j] * av[j]; } }
        u32x4 w; w.x = cvt_pk_bf16(o[0], o[1]); w.y = cvt_pk_bf16(o[2], o[3]); w.z = cvt_pk_bf16(o[4], o[5]); w.w = cvt_pk_bf16(o[6], o[7]);
        *(u32x4*)(xc + (size_t)m * 1024 + c0) = w;
    }
    LAS bf16_t* tl = (LAS bf16_t*)lds;
    for (int it = blockIdx.x; it < 32 * 65; it += gridDim.x) {
        const int bh = it / 65, tb = it - bh * 65, b = bh >> 3, h = bh & 7;
        __syncthreads();
#pragma unroll
        for (int i = 0; i < 2; ++i) { const int id = tid + 512 * i, row = id >> 4, c16 = id & 15;
            const u32x4 a = *(const u32x4*)(p5 + ((size_t)b * TP + tb * 64 + row) * LDP + C_V + h * 128 + c16 * 8);
            LAS unsigned* d = (LAS unsigned*)(tl + row * 130 + c16 * 8); d[0] = a.x; d[1] = a.y; d[2] = a.z; d[3] = a.w; }
        __syncthreads();
#pragma unroll
        for (int i = 0; i < 2; ++i) { const int id = tid + 512 * i, dv = id >> 3, c8 = id & 7; unsigned short e[8];
#pragma unroll
            for (int j = 0; j < 8; ++j) e[j] = tl[(c8 * 8 + j) * 130 + dv];
            u32x4 w; w.x = e[0] | ((unsigned)e[1] << 16); w.y = e[2] | ((unsigned)e[3] << 16); w.z = e[4] | ((unsigned)e[5] << 16); w.w = e[6] | ((unsigned)e[7] << 16);
            *(u32x4*)(vt + ((size_t)bh * 128 + dv) * TP + tb * 64 + c8 * 8) = w; }
    }
    __syncthreads();
}

__device__ __forceinline__ void lru_scan1(const bf16_t* p5, const bf16_t* bbuf, float* agg) {
    const int gt = blockIdx.x * 512 + opaque_tid(), NGT = gridDim.x * 512;
    for (int it = gt; it < NB * NCH64 * 512; it += NGT) {
        const int cp = it & 511, bc = it >> 9; const int b = bc / NCH64, c = bc - b * NCH64; const size_t m0 = (size_t)b * TP + c * 64;
        float s0 = 0.f, s1 = 0.f, h0 = 0.f, h1 = 0.f;
        for (int t0 = 0; t0 < 64; t0 += 16) {
            unsigned lw[16], bw[16];
#pragma unroll
            for (int k = 0; k < 16; ++k) { lw[k] = *(const unsigned*)(p5 + (m0 + t0 + k) * LDP + C_AX + 2 * cp); bw[k] = *(const unsigned*)(bbuf + (m0 + t0 + k) * 1024 + 2 * cp); }
#pragma unroll
            for (int k = 0; k < 16; ++k) { const float l0 = bf_lo(lw[k]), l1 = bf_hi(lw[k]); s0 += l0; s1 += l1; h0 = __expf(l0) * h0 + bf_lo(bw[k]); h1 = __expf(l1) * h1 + bf_hi(bw[k]); }
        }
        *(f32x4*)(agg + ((size_t)bc * 512 + cp) * 4) = (f32x4){s0, h0, s1, h1};
    }
}
__device__ __forceinline__ void lru_scan2(bf16_t* p5, const bf16_t* bbuf, const float* agg) {
    const int gt = blockIdx.x * 512 + opaque_tid(), NGT = gridDim.x * 512;
    for (int it = gt; it < NB * NCH64 * 512; it += NGT) {
        const int cp = it & 511, bc = it >> 9; const int b = bc / NCH64, c = bc - b * NCH64; const size_t m0 = (size_t)b * TP + c * 64;
        float h0 = 0.f, h1 = 0.f;
        for (int cc0 = 0; cc0 < c; cc0 += 8) {
            f32x4 a[8];
#pragma unroll
            for (int k = 0; k < 8; ++k) a[k] = (cc0 + k < c) ? *(const f32x4*)(agg + ((size_t)(b * NCH64 + cc0 + k) * 512 + cp) * 4) : (f32x4){0.f, 0.f, 0.f, 0.f};
#pragma unroll
            for (int k = 0; k < 8; ++k) { h0 = __expf(a[k].x) * h0 + a[k].y; h1 = __expf(a[k].z) * h1 + a[k].w; }
        }
        for (int t0 = 0; t0 < 64; t0 += 8) {
            unsigned lw[8], bw[8], gw[8];
#pragma unroll
            for (int k = 0; k < 8; ++k) { lw[k] = *(const unsigned*)(p5 + (m0 + t0 + k) * LDP + C_AX + 2 * cp); bw[k] = *(const unsigned*)(bbuf + (m0 + t0 + k) * 1024 + 2 * cp);
                gw[k] = *(const unsigned*)(p5 + (m0 + t0 + k) * LDP + C_AG + 2 * cp); }
#pragma unroll
            for (int k = 0; k < 8; ++k) { h0 = __expf(bf_lo(lw[k])) * h0 + bf_lo(bw[k]); h1 = __expf(bf_hi(lw[k])) * h1 + bf_hi(bw[k]);
                gw[k] = cvt_pk_bf16(h0 * gelu_tanh(bf_lo(gw[k])), h1 * gelu_tanh(bf_hi(gw[k]))); }
#pragma unroll
            for (int k = 0; k < 8; ++k) *(unsigned*)(p5 + (m0 + t0 + k) * LDP + C_AG + 2 * cp) = gw[k];
        }
    }
}
__device__ __forceinline__ void s5_carry(bf16_t* xh, const float* sb, const float* lam_re, const float* lam_im, const float* log_step) {
    const int gt = blockIdx.x * 512 + opaque_tid(), NGT = gridDim.x * 512;
    for (int it = gt; it < NB * 64 * 64; it += NGT) {
        const int p = it & 63, g = (it >> 6) & 63, b = it >> 12;
        const float lr = lam_re[g * 64 + p], li = lam_im[g * 64 + p], step = expf(log_step[g]);
        const float mag = expf(32.0f * lr * step); float s, c; sincosf(32.0f * li * step, &s, &c); const float ar = mag * c, ai = mag * s;
        float hr = 0.f, hi = 0.f;
        for (int ch0 = 0; ch0 < NCH32; ch0 += 10) {
            const size_t row0 = (size_t)g * XROWS + b * NCH32 + ch0; f32x2 sv[10];
#pragma unroll
            for (int k = 0; k < 10; ++k) sv[k] = *(const f32x2*)(sb + (row0 + k) * 128 + 2 * p);
#pragma unroll
            for (int k = 0; k < 10; ++k) {
                *(unsigned*)(xh + (row0 + k) * XLD + 512 + 2 * p) = cvt_pk_bf16(hr, hi);
                const float nr = ar * hr - ai * hi + sv[k].x, ni = ar * hi + ai * hr + sv[k].y; hr = nr; hi = ni; }
        }
    }
}

__device__ __forceinline__ float rows4_max(float v) {
    unsigned a = __float_as_uint(v); auto r = __builtin_amdgcn_permlane16_swap(a, a, false, false); v = fmaxf(__uint_as_float(r[0]), __uint_as_float(r[1]));
    a = __float_as_uint(v); auto r2 = __builtin_amdgcn_permlane32_swap(a, a, false, false); return fmaxf(__uint_as_float(r2[0]), __uint_as_float(r2[1])); }
__device__ __forceinline__ float rows4_sum(float v) {
    unsigned a = __float_as_uint(v); auto r = __builtin_amdgcn_permlane16_swap(a, a, false, false); v = __uint_as_float(r[0]) + __uint_as_float(r[1]);
    a = __float_as_uint(v); auto r2 = __builtin_amdgcn_permlane32_swap(a, a, false, false); return __uint_as_float(r2[0]) + __uint_as_float(r2[1]); }
constexpr int KPITCH = 272, VPITCH = 144, KBYTES = 64 * KPITCH, VBYTES = 128 * VPITCH;
__device__ __forceinline__ void attn_phase(LAS unsigned char* lds, bf16_t* p5, const bf16_t* vt, const float* relb, const float* dalam, const float* subln, float lam_init, int ocol) {
    const int tid = opaque_tid(), lane = tid & 63, wave = __builtin_amdgcn_readfirstlane(tid >> 6), lq = lane & 15, g4 = lane >> 4;
    const int cc = wave & 1, rgi = wave >> 1;
    LAS float* btab = (LAS float*)(lds + 2 * KBYTES + 2 * VBYTES);
    float lam;
    { float s1 = 0.f, s2 = 0.f; for (int i = 0; i < 64; ++i) { s1 += dalam[i] * dalam[64 + i]; s2 += dalam[128 + i] * dalam[192 + i]; } lam = expf(s1) - expf(s2) + lam_init; }
    const int c = blockIdx.x, G = gridDim.x;
    const float sc2 = 0.125f * LOG2E;
    for (int r = 0;; ++r) {
        const int idx = (r & 1) ? r * G + (G - 1 - c) : r * G + c;
        if (r * G >= 33 * 32) break;
        if (idx >= 33 * 32) continue;
        const int qt = 32 - idx / 32, bh = idx & 31, b = bh >> 3, h = bh & 7;
        const int njt = (2 * qt + 2) < 65 ? (2 * qt + 2) : 65;
        const int qrow0 = qt * 128 + rgi * 32;
        __syncthreads();
        if (tid < 128) { const int d = tid; int bk = d; if (d >= 16) { bk = 16 + (int)(logf((float)d * (1.0f / 16.0f)) * (16.0f / logf(8.0f))); if (bk > 31) bk = 31; } btab[d] = relb[bk * 8 + h] * LOG2E; }
        const float bfar = relb[31 * 8 + h] * LOG2E;
        bf16x8 qf[2][2];
#pragma unroll
        for (int rg = 0; rg < 2; ++rg) { const int q = qrow0 + 16 * rg + lq, qc = q < TP ? q : TP - 1;
#pragma unroll
            for (int s = 0; s < 2; ++s) qf[rg][s] = *(const bf16x8*)(p5 + ((size_t)b * TP + qc) * LDP + C_Q + h * 128 + cc * 64 + s * 32 + 8 * g4); }
        f32x4 O[2][8]; float mrow[2], lrow[2];
#pragma unroll
        for (int rg = 0; rg < 2; ++rg) { mrow[rg] = -INFINITY; lrow[rg] = 0.f;
#pragma unroll
            for (int k = 0; k < 8; ++k) O[rg][k] = (f32x4){0.f, 0.f, 0.f, 0.f}; }
        u32x4 kreg[2], vreg[2];
        const bf16_t* kbase = p5 + (size_t)b * TP * LDP + C_K + h * 128; const bf16_t* vbase = vt + (size_t)bh * 128 * TP;
#define ATT_LOAD(j) do { _Pragma("unroll") for (int i = 0; i < 2; ++i) { const int id = tid + 512 * i; \
            kreg[i] = *(const u32x4*)(kbase + (size_t)((j) * 64 + (id >> 4)) * LDP + (id & 15) * 8); \
            vreg[i] = *(const u32x4*)(vbase + (size_t)(id >> 3) * TP + (j) * 64 + (id & 7) * 8); } } while (0)
#define ATT_STORE(buf) do { _Pragma("unroll") for (int i = 0; i < 2; ++i) { const int id = tid + 512 * i; \
            *(LAS u32x4*)(lds + (buf) * KBYTES + (id >> 4) * KPITCH + (id & 15) * 16) = kreg[i]; \
            *(LAS u32x4*)(lds + 2 * KBYTES + (buf) * VBYTES + (id >> 3) * VPITCH + (id & 7) * 16) = vreg[i]; } } while (0)
        ATT_LOAD(0); ATT_STORE(0); __syncthreads();
        for (int j = 0; j < njt; ++j) {
            if (j + 1 < njt) ATT_LOAD(j + 1);
            if (j * 64 <= qrow0 + 31) {
                const LAS unsigned char* kb_ = lds + (j & 1) * KBYTES; const LAS unsigned char* vb_ = lds + 2 * KBYTES + (j & 1) * VBYTES;
                bf16x8 kf[4][2];
#pragma unroll
                for (int kb = 0; kb < 4; ++kb)
#pragma unroll
                    for (int s = 0; s < 2; ++s) kf[kb][s] = *(const LAS bf16x8*)(kb_ + (16 * kb + lq) * KPITCH + (cc * 64 + s * 32 + 8 * g4) * 2);
                __builtin_amdgcn_sched_barrier(0);
                f32x4 st[2][4];
#pragma unroll
                for (int kb = 0; kb < 4; ++kb)
#pragma unroll
                    for (int rg = 0; rg < 2; ++rg) { f32x4 a = (f32x4){0.f, 0.f, 0.f, 0.f};
#pragma unroll
                        for (int s = 0; s < 2; ++s) a = __builtin_amdgcn_mfma_f32_16x16x32_bf16(kf[kb][s], qf[rg][s], a, 0, 0, 0);
                        st[rg][kb] = a; }
                __builtin_amdgcn_sched_barrier(0);
#define ATT_VLOAD(dst, k0, nk) _Pragma("unroll") for (int k = 0; k < (nk); ++k) _Pragma("unroll") for (int s = 0; s < 2; ++s) { \
                    const LAS unsigned char* vp = vb_ + (16 * (k + (k0)) + lq) * VPITCH + (32 * s + 4 * g4) * 2; dst[k][s][0] = *(const LAS u32x2*)vp; dst[k][s][1] = *(const LAS u32x2*)(vp + 32); }
#define ATT_PV(src, k0, nk) _Pragma("unroll") for (int k = 0; k < (nk); ++k) _Pragma("unroll") for (int s = 0; s < 2; ++s) { \
                    const bf16x8 vf = __builtin_bit_cast(bf16x8, (u32x4){src[k][s][0].x, src[k][s][0].y, src[k][s][1].x, src[k][s][1].y}); \
                    O[0][k + (k0)] = __builtin_amdgcn_mfma_f32_16x16x32_bf16(vf, pk[0][s], O[0][k + (k0)], 0, 0, 0); \
                    O[1][k + (k0)] = __builtin_amdgcn_mfma_f32_16x16x32_bf16(vf, pk[1][s], O[1][k + (k0)], 0, 0, 0); }
                u32x2 va[1][2][2];
                ATT_VLOAD(va, 0, 1)
                __builtin_amdgcn_sched_barrier(0);
                const bool far = (j >= 1) && (j * 64 + 63 + 113 <= qrow0);
                bf16x8 pk[2][2];
#pragma unroll
                for (int rg = 0; rg < 2; ++rg) {
                    float rmax = -INFINITY, msafe, alpha;
                    if (far) {
#pragma unroll
                        for (int kb = 0; kb < 4; ++kb)
#pragma unroll
                            for (int i = 0; i < 4; ++i) rmax = fmaxf(rmax, st[rg][kb][i]);
                        rmax = rows4_max(rmax);
                        const float mnew = fmaxf(mrow[rg], rmax * sc2 + bfar); msafe = mnew;
                        alpha = __builtin_amdgcn_exp2f(mrow[rg] - msafe); mrow[rg] = mnew;
                        const float off = bfar - msafe;
#pragma unroll
                        for (int kb = 0; kb < 4; ++kb)
#pragma unroll
                            for (int i = 0; i < 4; ++i) st[rg][kb][i] = __builtin_amdgcn_exp2f(st[rg][kb][i] * sc2 + off);
                    } else {
                        const int q = qrow0 + 16 * rg + lq;
#pragma unroll
                        for (int kb = 0; kb < 4; ++kb)
#pragma unroll
                            for (int i = 0; i < 4; ++i) { float v = st[rg][kb][i] * sc2;
                                const int kp = j * 64 + 16 * kb + 4 * g4 + i; const int dist = q - kp;
                                const float bv = (dist >= 0 && dist < 128) ? btab[dist] : bfar;
                                v = (kp >= PADT && dist >= 0) ? v + bv : -INFINITY;
                                st[rg][kb][i] = v; rmax = fmaxf(rmax, v); }
                        rmax = rows4_max(rmax);
                        const float mnew = fmaxf(mrow[rg], rmax); msafe = (mnew == -INFINITY) ? 0.f : mnew;
                        alpha = __builtin_amdgcn_exp2f(mrow[rg] - msafe); mrow[rg] = mnew;
#pragma unroll
                        for (int kb = 0; kb < 4; ++kb)
#pragma unroll
                            for (int i = 0; i < 4; ++i) st[rg][kb][i] = __builtin_amdgcn_exp2f(st[rg][kb][i] - msafe);
                    }
                    float rs = 0.f;
#pragma unroll
                    for (int kb = 0; kb < 4; ++kb) rs += (st[rg][kb][0] + st[rg][kb][1]) + (st[rg][kb][2] + st[rg][kb][3]);
                    lrow[rg] = lrow[rg] * alpha + rs;
                    if (__builtin_amdgcn_ballot_w64(alpha != 1.0f) != 0ull) {
#pragma unroll
                        for (int k = 0; k < 8; ++k) O[rg][k] *= alpha; }
#pragma unroll
                    for (int s = 0; s < 2; ++s) { u32x4 w; w.x = cvt_pk_bf16(st[rg][2 * s][0], st[rg][2 * s][1]); w.y = cvt_pk_bf16(st[rg][2 * s][2], st[rg][2 * s][3]);
                        w.z = cvt_pk_bf16(st[rg][2 * s + 1][0], st[rg][2 * s + 1][1]); w.w = cvt_pk_bf16(st[rg][2 * s + 1][2], st[rg][2 * s + 1][3]);
                        pk[rg][s] = __builtin_bit_cast(bf16x8, w); }
                }
                __builtin_amdgcn_sched_barrier(0);
                u32x2 vc[3][2][2];
                ATT_VLOAD(vc, 1, 3)
                __builtin_amdgcn_sched_barrier(0);
                ATT_PV(va, 0, 1)
                __builtin_amdgcn_sched_barrier(0);
                u32x2 vd[2][2][2];
                ATT_VLOAD(vd, 4, 2)
                __builtin_amdgcn_sched_barrier(0);
                ATT_PV(vc, 1, 3)
                __builtin_amdgcn_sched_barrier(0);
                u32x2 ve[2][2][2];
                ATT_VLOAD(ve, 6, 2)
                __builtin_amdgcn_sched_barrier(0);
                ATT_PV(vd, 4, 2)
                __builtin_amdgcn_sched_barrier(0);
                ATT_PV(ve, 6, 2)
#undef ATT_VLOAD
#undef ATT_PV
            }
            if (j + 1 < njt) ATT_STORE((j + 1) & 1);
            __syncthreads();
        }
#undef ATT_LOAD
#undef ATT_STORE
        LAS f32x4* xch = (LAS f32x4*)lds + (size_t)rgi * 2 * 8 * 64 + lane;
#pragma unroll
        for (int rg = 0; rg < 2; ++rg) { const float l_ = rows4_sum(lrow[rg]); const float f = l_ > 0.f ? (cc ? lam : 1.0f) / l_ : 0.f;
#pragma unroll
            for (int k = 0; k < 8; ++k) { O[rg][k] *= f; if (cc) xch[(rg * 8 + k) * 64] = O[rg][k]; } }
        __syncthreads();
        if (cc == 0) {
#pragma unroll
            for (int rg = 0; rg < 2; ++rg) { const int q = qrow0 + 16 * rg + lq; float ss = 0.f;
#pragma unroll
                for (int k = 0; k < 8; ++k) { O[rg][k] -= xch[(rg * 8 + k) * 64]; ss += (O[rg][k].x * O[rg][k].x + O[rg][k].y * O[rg][k].y) + (O[rg][k].z * O[rg][k].z + O[rg][k].w * O[rg][k].w); }
                ss = rows4_sum(ss);
                const float rn = rsqrtf(ss * (1.0f / 128.0f) + 1e-5f) * (1.0f - lam_init);
                if (q < TP) {
#pragma unroll
                    for (int k = 0; k < 8; ++k) { const f32x4 w = *(const f32x4*)(subln + 16 * k + 4 * g4); const f32x4 o = O[rg][k] * rn * w;
                        *(u32x2*)(p5 + ((size_t)b * TP + q) * LDP + ocol + h * 128 + 16 * k + 4 * g4) = (u32x2){cvt_pk_bf16(o.x, o.y), cvt_pk_bf16(o.z, o.w)}; }
                }
            }
        }
    }
    __syncthreads();
}

#define XB_TMO      128
#define XB_XCNT(j)  (256  + 64 * (j))
#define XB_XSUB(j)  (1280 + 64 * (j))
#define XB_XGEN(j)  (2304 + 64 * (j))
#define XB_TOP      3328
#define XB_TOPGEN   3392
#define XCD_BAR_WORDS 3456
#define XB_SPIN_CAP (1u << 20)
__device__ __forceinline__ unsigned xb_ld(unsigned* p)              { return __hip_atomic_load(p, __ATOMIC_RELAXED, __HIP_MEMORY_SCOPE_AGENT); }
__device__ __forceinline__ unsigned xb_add(unsigned* p, unsigned v) { return __hip_atomic_fetch_add(p, v, __ATOMIC_RELAXED, __HIP_MEMORY_SCOPE_AGENT); }
__device__ __forceinline__ unsigned xb_xcc_id() { return (unsigned)__builtin_amdgcn_s_getreg((3 << 11) | 20) & 0xFu; }
#define XB_SPIN(cond, bar) do { unsigned _sp = 0; while (cond) { __builtin_amdgcn_s_sleep(1); \
    if ((++_sp & 255u) == 0u) { if (xb_ld(&(bar)[XB_TMO])) break; if (_sp > XB_SPIN_CAP) { atomicAdd(&(bar)[XB_TMO], 1u); break; } } } } while (0)
struct XcdBarrier { unsigned* bar; unsigned x; volatile LAS unsigned* st; };
__device__ __forceinline__ XcdBarrier xcd_barrier_post(unsigned* bar, volatile LAS unsigned* st) {
    XcdBarrier b; b.bar = bar; b.x = xb_xcc_id(); b.st = st;
    if (threadIdx.x == 0) (void)xb_add(&bar[XB_XCNT(b.x)], 1u);
    return b;
}
__device__ __forceinline__ void xcd_barrier_complete(unsigned* bar, unsigned x, unsigned& nloc, unsigned& nx) {
    const unsigned G = gridDim.x * gridDim.y * gridDim.z;
    unsigned sum, cnt, mine, sp = 0u;
    for (;;) {
        sum = 0u; cnt = 0u; mine = 0u;
#pragma unroll
        for (unsigned j = 0; j < 16; ++j) { const unsigned c = xb_ld(&bar[XB_XCNT(j)]); sum += c; cnt += (c > 0u) ? 1u : 0u; mine = (j == x) ? c : mine; }
        if (sum == G) break;
        __builtin_amdgcn_s_sleep(1);
        if ((++sp & 255u) == 0u) { if (xb_ld(&bar[XB_TMO])) break; if (sp > XB_SPIN_CAP) { atomicAdd(&bar[XB_TMO], 1u); break; } }
    }
    nloc = mine > 0u ? mine : 1u; nx = cnt > 0u ? cnt : 1u;
}
__device__ __forceinline__ void xcd_barrier(const XcdBarrier& b) {
    asm volatile("s_waitcnt vmcnt(0)" ::: "memory");
    __syncthreads();
    if (threadIdx.x == 0) {
        unsigned* bar = b.bar;
        __builtin_amdgcn_s_waitcnt(0);
        unsigned nloc = b.st[0], nx = b.st[1];
        if (nloc == 0u) { xcd_barrier_complete(bar, b.x, nloc, nx); b.st[0] = nloc; b.st[1] = nx; }
        const unsigned old = xb_add(&bar[XB_XSUB(b.x)], 1u);
        const unsigned gen = old / nloc;
        if (old + 1u == (gen + 1u) * nloc) {
            __builtin_amdgcn_fence(__ATOMIC_RELEASE, "agent");
            asm volatile("s_waitcnt vmcnt(0)" ::: "memory");
            const unsigned og = xb_add(&bar[XB_TOP], 1u);
            const unsigned tg = og / nx;
            if (og + 1u == (tg + 1u) * nx) xb_add(&bar[XB_TOPGEN], 1u);
            else XB_SPIN(xb_ld(&bar[XB_TOPGEN]) == tg, bar);
            __builtin_amdgcn_fence(__ATOMIC_ACQUIRE, "agent");
            xb_add(&bar[XB_XGEN(b.x)], 1u);
            asm volatile("s_waitcnt vmcnt(0)" ::: "memory");
        } else {
            XB_SPIN(xb_ld(&bar[XB_XGEN(b.x)]) == gen, bar);
            __builtin_amdgcn_fence(__ATOMIC_ACQUIRE, "agent");
            asm volatile("s_waitcnt vmcnt(0)" ::: "memory");
        }
    }
    __syncthreads();
}

#ifndef PROBE_DUP
#define PROBE_DUP 0
#endif
#ifndef PHM
#define PHM 0xFFFF
#endif
#define PH(b) if ((PHM >> (b)) & 1)
#define HB ((bf16_t*)(ws + WS_H))
#define P5 ((bf16_t*)(ws + WS_P5))
#define GT ((bf16_t*)(ws + WS_GT))
#define XC ((bf16_t*)(ws + WS_XC))
#define VT ((bf16_t*)(ws + WS_VT))
#define XH ((bf16_t*)(ws + WS_XH))
#define SB ((float*)(ws + WS_SB))
#define TPM ((bf16_t*)(ws + WS_TP))
#define W1M ((bf16_t*)(ws + WS_W1))
#define XSB ((bf16_t*)(ws + WS_XS))
#define AGG ((float*)(ws + WS_AGG))
#define LSG ((float*)(ws + WS_LSG))
#define MIX ((bf16_t*)(ws + WS_GT))
#define PART ((float*)(ws + WS_VT))
#define PART2 ((float*)(ws + WS_XC))
#define HID ((bf16_t*)(ws + WS_GT))
#define FFO ((bf16_t*)(ws + WS_P5))
#define WIN ((bf16_t*)(ws + WS_W + W_IN))
#define WBR ((bf16_t*)(ws + WS_W + W_BR))
#define WOUT ((bf16_t*)(ws + WS_W + W_OUT))
#define WGLU ((bf16_t*)(ws + WS_W + W_GLU))
#define WLRU ((bf16_t*)(ws + WS_W + W_LRU))
#define WF1 ((bf16_t*)(ws + WS_W + W_F1))
#define WF2 ((bf16_t*)(ws + WS_W + W_F2))
#define GASP __attribute__((address_space(1)))
#define PIN(i) ((const float*)(const GASP float*)(P.in[(i) + z]))
#define PHASE_BEGIN unsigned char* ws = opaque_ptr(P.ws); const int z = opaque_zero(); (void)ws; (void)z;
#define GSYNC() xcd_barrier(xbar)
constexpr int LDS_BYTES = 131072 + 1024;
__global__ void __launch_bounds__(512, 2) mega_fwd(Params P) {
    extern __shared__ __attribute__((aligned(16))) unsigned char lds_raw[];
    LAS unsigned char* lds = (LAS unsigned char*)lds_raw;
    cg::grid_group grid = cg::this_grid();
    const int G = gridDim.x, c = blockIdx.x;
    volatile LAS unsigned* bst = (volatile LAS unsigned*)(lds + 131072 + 512);
    if (threadIdx.x < 2) bst[threadIdx.x] = 0u;
    if (c == 0) for (int i = threadIdx.x; i < XCD_BAR_WORDS; i += 512) __hip_atomic_store((unsigned*)(P.ws + WS_BAR) + i, 0u, __ATOMIC_RELAXED, __HIP_MEMORY_SCOPE_AGENT);
    grid.sync();
    const XcdBarrier xbar = xcd_barrier_post((unsigned*)(P.ws + WS_BAR), bst);
    for (int l = 0; l < 2; ++l) {
        PH(0) { PHASE_BEGIN
            phase_norm(P, l == 0 ? 0 : 1, FFO, PIN(I_NORMW) + 3 * D, PIN(I_NORMW) + (size_t)l * 4 * D, HB, XSB, PART, 11); }
        for (int rep_ = 0; rep_ < ((PROBE_DUP & 16) ? 2 : 1); ++rep_) PH(1) { PHASE_BEGIN
            const int tid = opaque_tid(), lane = tid & 63, wave = __builtin_amdgcn_readfirstlane(tid >> 6); const int gw = c * 8 + wave, NGW = (G + z) * 8;
            const float* win = PIN(I_WIN) + (size_t)l * D * 12288; const float* wbr = PIN(I_WBR) + (size_t)l * 3 * 1024 * D; const float* wout = PIN(I_WOUT) + (size_t)l * D * D;
            const float* wglu = PIN(I_S5WG) + (size_t)l * 1024 * 1024;
            const int n_in = 32 * 48, n_br = 16 * 8, n_out = 32 * 8, n_glu = 16 * 4; const int tot = n_in + 3 * n_br + n_out + n_glu;
            { const int tot4 = tot * 4; const int s0 = (int)((unsigned)(gw * tot4) / (unsigned)NGW), s1 = (int)((unsigned)((gw + 1) * tot4) / (unsigned)NGW);
            for (int ss = s0; ss < s1; ++ss) {
                int r = ss >> 2; const int sub = ss & 3;
                if (r < n_in) { transpose_item<0>(win, D, 12288, WIN, r, sub, lane); continue; } r -= n_in;
                if (r < 3 * n_br) { const int i = r / n_br; transpose_item<0>(wbr + (size_t)i * 1024 * D, 1024, D, WBR + (size_t)i * D * 1024, r - i * n_br, sub, lane); continue; } r -= 3 * n_br;
                if (r < n_out) { transpose_item<0>(wout, D, D, WOUT, r, sub, lane); continue; } r -= n_out;
                transpose_item<0>(wglu, 1024, 1024, WGLU, r, sub, lane);
            } }
            const float* wa = PIN(I_LWA) + (size_t)l * 8 * 128 * 128; const float* wx = PIN(I_LWX) + (size_t)l * 8 * 128 * 128;
            for (int e = c * 512 + tid; e < 8 * 256 * 256; e += G * 512) { const int k = e & 255, n = (e >> 8) & 255, hh = e >> 16; float v = 0.f;
                if (k < 128) v = (n < 128) ? wa[((size_t)hh * 128 + k) * 128 + n] : wx[((size_t)hh * 128 + k) * 128 + (n - 128)];
                WLRU[e] = (bf16_t)(cvt_pk_bf16(v, 0.f) & 0xffffu); }
            if (c == 0) for (int e = tid; e < 1024; e += 512) LSG[e] = -8.0f * log1pf(expf(-(PIN(I_LLAM) + (size_t)l * 1024)[e]));
            __syncthreads();
            for (int t = c; t < 256; t += G)
                s5_gen_task(lds, t >> 2, t & 3, PIN(I_S5LR) + l * 4096, PIN(I_S5LI) + l * 4096, PIN(I_S5BR) + (size_t)l * 65536, PIN(I_S5BI) + (size_t)l * 65536,
                             PIN(I_S5CR) + (size_t)l * 65536, PIN(I_S5CI) + (size_t)l * 65536, PIN(I_S5LS) + l * 64, TPM, W1M);
        }
        GSYNC();
        PH(2) { PHASE_BEGIN
          pg8::DenseOrder S{HB, WIN, D, D, MP / 256, 12288 / 256, G, c, D / 64}; pg8::EpiG1 E{P5, XH, GT, PIN(I_BGATE) + (size_t)l * NGATE};
#if PROBE_DUP & 1
          pg8::gemm_phase(lds, D, D, S, E);
#endif
          pg8::gemm_phase(lds, D, D, S, E); }
        GSYNC();
        for (int rep_ = 0; rep_ < ((PROBE_DUP & 64) ? 2 : 1); ++rep_) PH(3) { PHASE_BEGIN
          phase_prep(lds, P5, XC, VT, PIN(I_CONVW) + (size_t)l * 4096, PIN(I_CONVB) + (size_t)l * 1024); }
        GSYNC();
        PH(4) { PHASE_BEGIN
          pg8::GroupOrder S{XC, WLRU, 1024, 256, MP / 256, 1, 8, 0, 256, 128, G, c, 4};
          pg8::EpiLru E{P5, XC, PIN(I_LBA) + (size_t)l * 1024, PIN(I_LBX) + (size_t)l * 1024, LSG};
          pg8::gemm_phase(lds, 1024, 256, S, E); }
        PH(5) { PHASE_BEGIN
          pg8::GroupOrder S{XH, W1M, XLD, 512, 3, 1, 64, XROWS, 128, 0, G, c, 8}; pg8::EpiS5S E{SB};
          pg8::gemm_phase(lds, XLD, 512, S, E); }
        PH(6) { PHASE_BEGIN
          const float lam_init = 0.8f - 0.6f * expf(-0.3f * (float)l);
#if PROBE_DUP & 2
          attn_phase(lds, P5, VT, PIN(I_RELB), PIN(I_DALAM) + (size_t)l * 256, PIN(I_DASUB) + (size_t)l * 128, lam_init, C_V);
#endif
          attn_phase(lds, P5, VT, PIN(I_RELB), PIN(I_DALAM) + (size_t)l * 256, PIN(I_DASUB) + (size_t)l * 128, lam_init, C_Q); }
        GSYNC();
        for (int rep_ = 0; rep_ < ((PROBE_DUP & 128) ? 2 : 1); ++rep_) PH(7) { PHASE_BEGIN
          lru_scan1(P5, XC, AGG);
          s5_carry(XH, SB, PIN(I_S5LR) + l * 4096, PIN(I_S5LI) + l * 4096, PIN(I_S5LS) + l * 64); }
        GSYNC();
        PH(8) { PHASE_BEGIN
          pg8::GroupOrder S{XH, TPM, XLD, XLD, 3, 2, 64, XROWS, 512, 0, G, c, 10}; pg8::EpiS5Y E{P5, XH, PIN(I_S5D) + (size_t)l * 1024};
          pg8::gemm_phase(lds, XLD, XLD, S, E); }
        PH(7) { PHASE_BEGIN
          lru_scan2(P5, XC, AGG); }
        GSYNC();
        PH(9) { PHASE_BEGIN
          pg8::DenseOrder S{P5 + C_V, WGLU, LDP, 1024, MP / 256, 4, G, c, 16}; pg8::EpiGlu E{P5, PIN(I_S5BG) + (size_t)l * 1024};
          pg8::gemm_phase(lds, LDP, 1024, S, E); }
        GSYNC();
        PH(10) { PHASE_BEGIN
          pg8::BranchOrder S{P5, WBR, LDP, 1024, MP / 256, 8, G, c, 16, 4}; pg8::EpiG2 E{GT, (u32x4*)(ws + WS_XH) + (size_t)c * 16 * 512, HB, PART2, 4};
          pg8::gemm_phase(lds, LDP, 1024, S, E); }
        GSYNC();
        PH(10) { PHASE_BEGIN
          pg8::g2_tail_reduce(PART2, 4, HB); }
        GSYNC();
        PH(11) { PHASE_BEGIN
          pg8::SplitOrder S{HB, WOUT, D, D, MP / 256, 8, G, c, D / 64, 4, 8}; pg8::EpiMix E{MIX, D, PART, 4};
          pg8::gemm_phase(lds, D, D, S, E); }
        GSYNC();
        PH(0) { PHASE_BEGIN
          const float* nw = PIN(I_NORMW) + (size_t)l * 4 * D;
          phase_norm(P, l == 0 ? 3 : 1, MIX, nw + D, nw + 2 * D, HB, XSB, PART, 4); }
        for (int rep_ = 0; rep_ < ((PROBE_DUP & 32) ? 2 : 1); ++rep_) PH(1) { PHASE_BEGIN
            const int tid = opaque_tid(), lane = tid & 63, wave = __builtin_amdgcn_readfirstlane(tid >> 6); const int gw = c * 8 + wave, NGW = (G + z) * 8;
            const float* wf1 = PIN(I_WF1) + (size_t)l * D * 2 * DFF; const float* wf2 = PIN(I_WF2) + (size_t)l * DFF * D;
            const int n1 = 32 * 44, n2 = 88 * 8;
            { const int tot4 = (n1 + n2) * 4; const int s0 = (int)((unsigned)(gw * tot4) / (unsigned)NGW), s1 = (int)((unsigned)((gw + 1) * tot4) / (unsigned)NGW);
            for (int ss = s0; ss < s1; ++ss) {
                const int it = ss >> 2, sub = ss & 3;
                if (it < n1) transpose_item<1>(wf1, D, 2 * DFF, WF1, it, sub, lane);
                else transpose_item<0>(wf2, DFF, D, WF2, it - n1, sub, lane);
            } }
        }
        GSYNC();
        PH(12) { PHASE_BEGIN
          pg8::DenseOrder S{HB, WF1, D, D, MP / 256, 44, G, c, D / 64}; pg8::EpiSwiglu E{HID};
#if PROBE_DUP & 256
          pg8::gemm_phase(lds, D, D, S, E);
#endif
          pg8::gemm_phase(lds, D, D, S, E); }
        GSYNC();
        PH(11) { PHASE_BEGIN
          pg8::SplitOrder S{HID, WF2, DFF, DFF, MP / 256, 8, G, c, DFF / 64, 11, 8}; pg8::EpiMix E{FFO, D, PART, 11};
#if PROBE_DUP & 8
          pg8::gemm_phase(lds, DFF, DFF, S, E);
#endif
          pg8::gemm_phase(lds, DFF, DFF, S, E); }
        GSYNC();
    }
    PH(0) { PHASE_BEGIN
      phase_norm(P, 2, FFO, PIN(I_NORMW) + (size_t)(4 + 3) * D, nullptr, HB, XSB, PART, 11); }
}

extern "C" void kernel_launch(void* const* d_in, const int* in_sizes, int n_in, void* d_out, int out_size, void* d_ws, size_t ws_size, hipStream_t stream) {
    static int grid_blocks = 0;
    if (!grid_blocks) {
        int dev = 0, cus = 0, per_cu = 0;
        hipGetDevice(&dev);
        hipDeviceGetAttribute(&cus, hipDeviceAttributeMultiprocessorCount, dev);
        hipFuncSetAttribute((const void*)mega_fwd, hipFuncAttributeMaxDynamicSharedMemorySize, LDS_BYTES);
        hipOccupancyMaxActiveBlocksPerMultiprocessor(&per_cu, (const void*)mega_fwd, 512, LDS_BYTES);
        if (per_cu < 1) per_cu = 1;
        grid_blocks = cus * per_cu;
        if (ws_size < WS_END) fprintf(stderr, "kernel_launch: workspace too small: %zu < %zu\n", ws_size, (size_t)WS_END);
    }
    Params p{};
    for (int i = 0; i < 29; ++i) p.in[i] = (const float*)d_in[i];
    p.out = (float*)d_out; p.ws = (unsigned char*)d_ws;
    void* args[] = {&p};
    hipError_t e = hipLaunchCooperativeKernel((const void*)mega_fwd, dim3(grid_blocks), dim3(512), args, LDS_BYTES, stream);
    if (e != hipSuccess) fprintf(stderr, "cooperative launch failed: %s (grid %d)\n", hipGetErrorString(e), grid_blocks);
}
```

```cpp
#include <hip/hip_runtime.h>
#include <hip/hip_cooperative_groups.h>
#include <cstdio>
#include <cstdint>
namespace cg = cooperative_groups;

#define LAS __attribute__((address_space(3)))
typedef unsigned short bf16_t;
typedef short bf16x8 __attribute__((ext_vector_type(8)));
typedef short bf16x4 __attribute__((ext_vector_type(4)));
typedef float f32x4 __attribute__((ext_vector_type(4)));
typedef float f32x2 __attribute__((ext_vector_type(2)));
typedef unsigned u32x4 __attribute__((ext_vector_type(4)));
typedef unsigned u32x2 __attribute__((ext_vector_type(2)));

constexpr int NB = 4, SEQ = 4096, PADT = 48, TP = 4160, MP = NB * TP;
constexpr int D = 2048, DFF = 5632, LDP = 5120, NGATE = 6144;
constexpr int C_AG = 0, C_AX = 1024, C_Q = 2048, C_K = 3072, C_V = 4096;
constexpr int NCH32 = 130, XROWS = 768, XLD = 640;
constexpr int NCH64 = 65;
constexpr float LOG2E = 1.4426950408889634f;

constexpr size_t MiB = 1u << 20;
constexpr size_t WS_W = 0;
constexpr size_t W_IN = 0, W_BR = 48 * MiB, W_OUT = 60 * MiB, W_GLU = 68 * MiB, W_LRU = 70 * MiB;
constexpr size_t W_F1 = 0, W_F2 = 44 * MiB;
constexpr size_t WS_H = 72 * MiB;
constexpr size_t WS_P5 = 137 * MiB;
constexpr size_t WS_GT = 300 * MiB;
constexpr size_t WS_XC = 495 * MiB;
constexpr size_t WS_VT = 528 * MiB;
constexpr size_t WS_XH = 561 * MiB;
constexpr size_t WS_SB = 621 * MiB;
constexpr size_t WS_TP = 645 * MiB;
constexpr size_t WS_W1 = 685 * MiB;
constexpr size_t WS_AGG = 694 * MiB;
constexpr size_t WS_LSG = 697 * MiB;
constexpr size_t WS_BAR = 697 * MiB + 65536;
constexpr size_t WS_XS = 698 * MiB;
constexpr size_t WS_END = 763 * MiB;

struct Params { const float* in[29]; float* out; unsigned char* ws; };
enum { I_X = 0, I_META, I_RELB, I_NORMW, I_WIN, I_CONVW, I_CONVB, I_LWA, I_LBA, I_LWX, I_LBX, I_LLAM, I_DALAM, I_DASUB, I_S5LR, I_S5LI,
       I_S5BR, I_S5BI, I_S5CR, I_S5CI, I_S5D, I_S5LS, I_S5WG, I_S5BG, I_BGATE, I_WBR, I_WOUT, I_WF1, I_WF2 };

__device__ __forceinline__ int opaque_zero() { int z = 0; asm volatile("" : "+v"(z)); return __builtin_amdgcn_readfirstlane(z); }
__device__ __forceinline__ unsigned char* opaque_ptr(unsigned char* p) { const unsigned long long u = (unsigned long long)p; int lo = (int)(unsigned)u, hi = (int)(unsigned)(u >> 32);
    asm volatile("" : "+v"(lo), "+v"(hi)); lo = __builtin_amdgcn_readfirstlane(lo); hi = __builtin_amdgcn_readfirstlane(hi);
    return (unsigned char*)(__attribute__((address_space(1))) unsigned char*)(((unsigned long long)(unsigned)hi << 32) | (unsigned)lo); }
__device__ __forceinline__ int opaque_tid() { int t = threadIdx.x; asm volatile("" : "+v"(t)); return t; }
__device__ __forceinline__ unsigned cvt_pk_bf16(float lo, float hi) { unsigned r; asm volatile("v_cvt_pk_bf16_f32 %0, %1, %2" : "=v"(r) : "v"(lo), "v"(hi)); return r; }
__device__ __forceinline__ float bf_lo(unsigned w) { return __uint_as_float(w << 16); }
__device__ __forceinline__ float bf_hi(unsigned w) { return __uint_as_float(w & 0xffff0000u); }
__device__ __forceinline__ float bf2f(bf16_t v) { return __uint_as_float(((unsigned)v) << 16); }
__device__ __forceinline__ float sigmoidf_(float x) { return __builtin_amdgcn_rcpf(1.0f + __builtin_amdgcn_exp2f(-1.4426950408889634f * x)); }
__device__ __forceinline__ float gelu_tanh(float x) { const float u = 1.5957691216057308f * (x + 0.044715f * x * x * x); return x * sigmoidf_(u); }
__device__ __forceinline__ float wave_sum(float v) {
    v += __builtin_bit_cast(float, __builtin_amdgcn_update_dpp(0, __builtin_bit_cast(int, v), 0xB1, 0xF, 0xF, true));
    v += __builtin_bit_cast(float, __builtin_amdgcn_update_dpp(0, __builtin_bit_cast(int, v), 0x4E, 0xF, 0xF, true));
    v += __builtin_bit_cast(float, __builtin_amdgcn_update_dpp(0, __builtin_bit_cast(int, v), 0x124, 0xF, 0xF, true));
    v += __builtin_bit_cast(float, __builtin_amdgcn_update_dpp(0, __builtin_bit_cast(int, v), 0x128, 0xF, 0xF, true));
    unsigned a = __float_as_uint(v); auto r = __builtin_amdgcn_permlane16_swap(a, a, false, false); v = __uint_as_float(r[0]) + __uint_as_float(r[1]);
    a = __float_as_uint(v); auto r2 = __builtin_amdgcn_permlane32_swap(a, a, false, false); return __uint_as_float(r2[0]) + __uint_as_float(r2[1]);
}
__device__ __forceinline__ float* xs_row(float* out, float* metab, int m) {
    const int b = m / TP, tp = m - b * TP;
    if (tp < PADT) return nullptr;
    if (tp < 64) return metab + (size_t)(b * 16 + tp - PADT) * D;
    return out + ((size_t)b * SEQ + (tp - 64)) * D;
}

namespace pg8 {
constexpr int BM = 256, BK = 64, HALF = 128, HTB = HALF * BK * 2, STAGE_BYTES = 8 * HTB, NXCD = 8, WGM = 8;
__device__ __forceinline__ int lds_byte(int r, int c) { const int st = (r >> 4) * 2 + (c >> 5), rr = r & 15, cc = c & 31, ob = rr * 64 + cc * 2; return st * 1024 + (ob ^ (((ob >> 9) & 1) << 5)); }
__device__ __forceinline__ void stage_rc(int b, int& R, int& C) { const int st = b / 1024, sb = b % 1024, swz = sb ^ (((sb >> 9) & 1) << 5); R = (st >> 1) * 16 + swz / 64; C = (st & 1) * 32 + (swz % 64) / 2; }
__device__ __forceinline__ int perm32(int rho) { const int n = rho >> 4, i = rho & 15; return 8 * (i >> 2) + 4 * n + (i & 3); }

struct Unit { const char* A; const char* B; int pm, pn, aux, nt; };

__device__ __forceinline__ void dense_tile(int L, int nM, int nN, int& pm, int& pn) {
    const int nwg = nM * nN; int wgid = L;
    { const int q = nwg / NXCD, r = nwg % NXCD, xcd = wgid % NXCD, off = wgid / NXCD; wgid = (xcd < r ? xcd * (q + 1) : r * (q + 1) + (xcd - r) * q) + off; }
    const int nig = WGM * nN, gid = wgid / nig, fm = gid * WGM, gsz = (nM - fm) < WGM ? (nM - fm) : WGM;
    pm = fm + ((wgid % nig) % gsz); pn = (wgid % nig) / gsz;
}
struct DenseOrder {
    const bf16_t* A; const bf16_t* Bt; int lda, ldb, nM, nN, G, c, ntk;
    __device__ __forceinline__ bool next(int i, Unit& u) const {
        const int L = i * G + c; if (L >= nM * nN) return false;
        int pm, pn; dense_tile(L, nM, nN, pm, pn);
        u.pm = pm; u.pn = pn; u.aux = 0; u.nt = ntk;
        u.A = (const char*)(A + (size_t)pm * 256 * lda); u.B = (const char*)(Bt + (size_t)pn * 256 * ldb); return true;
    }
};
struct SplitOrder {
    const bf16_t* A; const bf16_t* Bt; int lda, ldb, nM, nN, G, c, ntk, pieces, nt_piece;
    __device__ __forceinline__ bool next(int i, Unit& u) const {
        const int nfull = (nM - 1) * nN; const int L = i * G + c; int pm, pn, pc = 0, full = 1;
        if (L < nfull) dense_tile(L, nM - 1, nN, pm, pn);
        else { const int s_ = L - nfull; if (s_ >= nN * pieces) return false; pn = s_ / pieces; pc = s_ - pn * pieces; pm = nM - 1; full = 0; }
        u.pm = pm; u.pn = pn; u.aux = full ? 0 : 1 + pc; u.nt = full ? ntk : nt_piece;
        u.A = (const char*)(A + (size_t)pm * 256 * lda + (size_t)pc * nt_piece * 64); u.B = (const char*)(Bt + (size_t)pn * 256 * ldb + (size_t)pc * nt_piece * 64); return true;
    }
};
struct BranchOrder {
    const bf16_t* A0; const bf16_t* Bt; int lda, ldb, nM, nN, G, c, ntk, pieces;
    __device__ __forceinline__ bool next(int i, Unit& u) const {
        const int nfull = (nM - 1) * nN, rounds = nfull / G;
        int pm, pn, br, pc = 0;
        if (i < 3 * rounds) { const int r = i / 3; br = i - 3 * r; dense_tile(r * G + c, nM - 1, nN, pm, pn); u.nt = ntk; u.aux = br; }
        else { const int s_ = (i - 3 * rounds) * G + c; if (s_ >= nN * 3 * pieces) return false;
            pn = s_ / (3 * pieces); const int rem = s_ - pn * 3 * pieces; br = rem / pieces; pc = rem - br * pieces; pm = nM - 1; u.nt = ntk / pieces; u.aux = br | ((1 + pc) << 2); }
        u.pm = pm; u.pn = pn;
        const int acol = br == 0 ? C_AG : (br == 1 ? C_Q : C_K);
        u.A = (const char*)(A0 + (size_t)pm * 256 * lda + acol + (size_t)pc * (ntk / pieces) * 64);
        u.B = (const char*)(Bt + (size_t)br * 2048 * 1024 + (size_t)pn * 256 * ldb + (size_t)pc * (ntk / pieces) * 64); return true;
    }
};
struct GroupOrder {
    const bf16_t* A; const bf16_t* Bt; int lda, ldb, nM, nN, ngroups, a_gstride_rows, b_gstride_rows, a_gcol, G, c, ntk;
    __device__ __forceinline__ bool next(int i, Unit& u) const {
        const int L = i * G + c; const int per = nM * nN; if (L >= per * ngroups) return false;
        const int g = L / per, r = L - g * per; const int pm = r / nN, pn = r - pm * nN;
        u.pm = pm; u.pn = pn; u.aux = g; u.nt = ntk;
        u.A = (const char*)(A + ((size_t)g * a_gstride_rows + (size_t)pm * 256) * lda + (size_t)g * a_gcol);
        u.B = (const char*)(Bt + ((size_t)g * b_gstride_rows + (size_t)pn * 256) * ldb); return true;
    }
};

template <class Epi, class Sched>
__device__ __forceinline__ void gemm_phase(LAS unsigned char* lds, const int lda, const int ldb, const Sched& S, const Epi& E) {
    int tid_ = threadIdx.x; asm volatile("" : "+v"(tid_));
    const int tid = tid_, wid = __builtin_amdgcn_readfirstlane(tid >> 6), lane = tid & 63, wr = wid >> 2, wc = wid & 3, fr = lane & 15, fq = lane >> 4;
    unsigned voffA[2], voffB[2];
#pragma unroll
    for (int i = 0; i < 2; ++i) { int R, C; stage_rc(tid * 16 + i * 8192, R, C); const int Rb = Epi::PERM ? ((R & ~31) + perm32(R & 31)) : R;
        voffA[i] = (unsigned)(R * lda + C) * 2u; voffB[i] = (unsigned)(Rb * ldb + C) * 2u; }
    const size_t kstep = (size_t)(BK * 2);
    const size_t hstepA = (size_t)HALF * lda * 2, hstepB = (size_t)HALF * ldb * 2;
    const unsigned ldsw = (unsigned)wid * 1024u;
    const int aoff = lds_byte(wr * 64 + fr, fq * 8), boff = lds_byte(wc * 32 + fr, fq * 8);
#define PG8_SA(b, h) (((b) * 2 + (h)) * HTB)
#define PG8_SB(b, h) ((4 + (b) * 2 + (h)) * HTB)
#define PG8_STAGE(bufoff, gbase, voff) do { _Pragma("unroll") for (int _i = 0; _i < 2; ++_i) \
        __builtin_amdgcn_global_load_lds((const unsigned*)((const char*)(gbase) + (voff)[_i]), (LAS unsigned*)(lds + (bufoff) + ldsw + _i * 8192), 16, 0, 0); } while (0)
#define PG8_LDA(dst, b, h) do { _Pragma("unroll") for (int m = 0; m < 4; ++m) _Pragma("unroll") for (int k = 0; k < 2; ++k) dst[m][k] = *(const LAS bf16x8*)(lds + PG8_SA(b, h) + aoff + m * 2048 + k * 1024); } while (0)
#define PG8_LDB(dst, b, h) do { _Pragma("unroll") for (int n = 0; n < 2; ++n) _Pragma("unroll") for (int k = 0; k < 2; ++k) dst[n][k] = *(const LAS bf16x8*)(lds + PG8_SB(b, h) + boff + n * 2048 + k * 1024); } while (0)
#define PG8_MMA(ai, bj, At, Bt) do { __builtin_amdgcn_s_setprio(1); _Pragma("unroll") for (int m = 0; m < 4; ++m) _Pragma("unroll") for (int n = 0; n < 2; ++n) _Pragma("unroll") for (int k = 0; k < 2; ++k) \
        acc[ai][bj][m][n] = __builtin_amdgcn_mfma_f32_16x16x32_bf16(Bt[n][k], At[m][k], acc[ai][bj][m][n], 0, 0, 0); __builtin_amdgcn_s_setprio(0); } while (0)
#define PG8_WAIT_V(n) asm volatile("s_waitcnt vmcnt(" #n ")" ::: "memory")
#define PG8_WAIT_L(n) asm volatile("s_waitcnt lgkmcnt(" #n ")" ::: "memory")
#define PG8_BAR __builtin_amdgcn_s_barrier()
#define PG8_SCHED __builtin_amdgcn_sched_barrier(0)
    Unit cur, nxt; int ui = 0;
    if (!S.next(0, cur)) return;
    f32x4 acc[2][2][4][2];
#pragma unroll
    for (int a = 0; a < 2; ++a)
#pragma unroll
        for (int b = 0; b < 2; ++b)
#pragma unroll
            for (int m = 0; m < 4; ++m)
#pragma unroll
                for (int n = 0; n < 2; ++n) acc[a][b][m][n] = (f32x4){0.f, 0.f, 0.f, 0.f};
    bf16x8 At[4][2], B0[2][2], B1[2][2];
    const char* cA = cur.A; const char* cB = cur.B; asm volatile("" : "+s"(cA), "+s"(cB));
    PG8_STAGE(PG8_SB(0, 0), cB, voffB); PG8_STAGE(PG8_SB(0, 1), cB + hstepB, voffB); PG8_STAGE(PG8_SA(0, 0), cA, voffA); PG8_STAGE(PG8_SA(0, 1), cA + hstepA, voffA);
    if (wr == 1) PG8_BAR;
    PG8_WAIT_V(2); PG8_BAR;
    PG8_STAGE(PG8_SB(1, 0), cB + kstep, voffB); PG8_STAGE(PG8_SA(1, 0), cA + kstep, voffA); PG8_STAGE(PG8_SB(1, 1), cB + hstepB + kstep, voffB);
    PG8_WAIT_V(6); PG8_BAR;
    for (;;) {
        const bool has_next = S.next(ui + 1, nxt);
        const char* nA = has_next ? nxt.A : cA; const char* nB = has_next ? nxt.B : cB;
        const int nt = cur.nt;
#pragma unroll 1
        for (int t = 0; t < nt; t += 2) {
            const bool last = (t == nt - 2);
            const char* a1 = cA + (size_t)(t + 1) * kstep;
            const char* a2 = last ? nA : cA + (size_t)(t + 2) * kstep; const char* b2 = last ? nB : cB + (size_t)(t + 2) * kstep;
            const char* a3 = a2 + kstep; const char* b3 = b2 + kstep;
            PG8_LDB(B0, 0, 0); PG8_LDB(B1, 0, 1); PG8_SCHED; PG8_LDA(At, 0, 0); PG8_STAGE(PG8_SA(1, 1), a1 + hstepA, voffA);
            PG8_WAIT_V(8); PG8_WAIT_L(0); PG8_BAR; PG8_MMA(0, 0, At, B0); PG8_MMA(0, 1, At, B1); PG8_BAR; PG8_SCHED;
            PG8_LDA(At, 0, 1); PG8_STAGE(PG8_SB(0, 0), b2, voffB); PG8_STAGE(PG8_SB(0, 1), b2 + hstepB, voffB); PG8_STAGE(PG8_SA(0, 0), a2, voffA);
            PG8_WAIT_V(8); PG8_WAIT_L(0); PG8_BAR; PG8_MMA(1, 0, At, B0); PG8_MMA(1, 1, At, B1); PG8_BAR; PG8_SCHED;
            PG8_LDB(B0, 1, 0); PG8_LDB(B1, 1, 1); PG8_SCHED; PG8_LDA(At, 1, 0); PG8_STAGE(PG8_SA(0, 1), a2 + hstepA, voffA);
            PG8_WAIT_V(8); PG8_WAIT_L(0); PG8_BAR; PG8_MMA(0, 0, At, B0); PG8_MMA(0, 1, At, B1); PG8_BAR; PG8_SCHED;
            PG8_LDA(At, 1, 1); PG8_STAGE(PG8_SB(1, 0), b3, voffB); PG8_STAGE(PG8_SB(1, 1), b3 + hstepB, voffB); PG8_STAGE(PG8_SA(1, 0), a3, voffA);
            PG8_WAIT_V(8); PG8_WAIT_L(0); PG8_BAR; PG8_MMA(1, 0, At, B0); PG8_MMA(1, 1, At, B1); PG8_BAR; PG8_SCHED;
        }
        if (wr == 0) PG8_BAR;
        { const int t2 = opaque_tid(); const int w2 = __builtin_amdgcn_readfirstlane(t2 >> 6); E(acc, cur, w2 >> 2, w2 & 3, t2 & 15, (t2 & 63) >> 4); }
        if (!has_next) break;
#pragma unroll
        for (int a = 0; a < 2; ++a)
#pragma unroll
            for (int b = 0; b < 2; ++b)
#pragma unroll
                for (int m = 0; m < 4; ++m)
#pragma unroll
                    for (int n = 0; n < 2; ++n) acc[a][b][m][n] = (f32x4){0.f, 0.f, 0.f, 0.f};
        cur = nxt; cA = nA; cB = nB; ++ui;
        if (wr == 1) PG8_BAR;
    }
    PG8_WAIT_V(0);
    PG8_BAR;
#undef PG8_SA
#undef PG8_SB
#undef PG8_STAGE
#undef PG8_LDA
#undef PG8_LDB
#undef PG8_MMA
#undef PG8_WAIT_V
#undef PG8_WAIT_L
#undef PG8_BAR
#undef PG8_SCHED
}

typedef f32x4 Acc[2][2][4][2];

struct EpiG1 {
    static constexpr bool PERM = true;
    bf16_t* p5; bf16_t* xh; bf16_t* gates; const float* bgate;
    __device__ __forceinline__ void operator()(const Acc& acc, const Unit& u, int wr, int wc, int fr, int fq) const {
        const int row0 = u.pm * 256 + wr * 64 + fr; const int pn = u.pn;
        f32x4 gb[2][2];
#pragma unroll
        for (int bj = 0; bj < 2; ++bj) { const int cg_ = (pn >= 24 ? (pn - 24) * 256 : 0) + bj * 128 + wc * 32 + 8 * fq;
            gb[bj][0] = *(const f32x4*)(bgate + cg_); gb[bj][1] = *(const f32x4*)(bgate + cg_ + 4); }
#pragma unroll
        for (int ai = 0; ai < 2; ++ai)
#pragma unroll
            for (int m = 0; m < 4; ++m) {
                const int row = row0 + ai * 128 + m * 16;
#pragma unroll
                for (int bj = 0; bj < 2; ++bj) {
                    const int colt = bj * 128 + wc * 32 + 8 * fq;
                    f32x4 v0 = acc[ai][bj][m][0], v1 = acc[ai][bj][m][1];
                    bf16_t* dst;
                    if (pn < 20) dst = p5 + (size_t)row * LDP + pn * 256 + colt;
                    else if (pn < 24) {
                        const int cu = (pn - 20) * 256 + colt, g = cu >> 4, c0 = cu & 15;
                        const int b = row / TP, tp = row - b * TP, chunk = tp >> 5, jj = tp & 31;
                        dst = xh + ((size_t)g * XROWS + b * NCH32 + chunk) * XLD + jj * 16 + c0;
                    } else {
                        const int cg_ = (pn - 24) * 256 + colt;
                        unsigned q0 = 0u, q1 = 0u;
#pragma unroll
                        for (int j = 0; j < 4; ++j) { q0 |= (unsigned)(sigmoidf_(v0[j] + gb[bj][0][j]) * 255.0f + 0.5f) << (8 * j); q1 |= (unsigned)(sigmoidf_(v1[j] + gb[bj][1][j]) * 255.0f + 0.5f) << (8 * j); }
                        *(u32x2*)((unsigned char*)gates + (size_t)row * NGATE + cg_) = (u32x2){q0, q1};
                        continue;
                    }
                    u32x4 w; w.x = cvt_pk_bf16(v0[0], v0[1]); w.y = cvt_pk_bf16(v0[2], v0[3]); w.z = cvt_pk_bf16(v1[0], v1[1]); w.w = cvt_pk_bf16(v1[2], v1[3]);
                    *(u32x4*)dst = w;
                }
            }
    }
};
struct EpiLru {
    static constexpr bool PERM = true;
    bf16_t* p5; bf16_t* xc; const float* ba; const float* bx; const float* lsgp;
    __device__ __forceinline__ void operator()(const Acc& acc, const Unit& u, int wr, int wc, int fr, int fq) const {
        const int row0 = u.pm * 256 + wr * 64 + fr; int chb = u.aux * 128 + wc * 32 + 8 * fq; asm volatile("" : "+v"(chb));
#pragma unroll
        for (int n = 0; n < 2; ++n) {
            const int ch0 = chb + 4 * n;
            const f32x4 lsg = *(const f32x4*)(lsgp + ch0), bav = *(const f32x4*)(ba + ch0), bxv = *(const f32x4*)(bx + ch0);
            u32x2 xw[2][4];
#pragma unroll
            for (int ai = 0; ai < 2; ++ai)
#pragma unroll
                for (int m = 0; m < 4; ++m) xw[ai][m] = *(const u32x2*)(xc + (size_t)(row0 + ai * 128 + m * 16) * 1024 + ch0);
#pragma unroll
            for (int ai = 0; ai < 2; ++ai)
#pragma unroll
                for (int m = 0; m < 4; ++m) {
                    const int row = row0 + ai * 128 + m * 16; const int tp = row % TP;
                    const float xv[4] = {bf_lo(xw[ai][m].x), bf_hi(xw[ai][m].x), bf_lo(xw[ai][m].y), bf_hi(xw[ai][m].y)};
                    float la[4], bb[4];
#pragma unroll
                    for (int j = 0; j < 4; ++j) {
                        const float rp = acc[ai][0][m][n][j], ip = acc[ai][1][m][n][j];
                        const float l_ = lsg[j] * sigmoidf_(rp + bav[j]);
                        la[j] = l_;
                        const float t2 = 1.0f - __expf(2.0f * l_);
                        bb[j] = (tp < PADT) ? 0.0f : sqrtf(fmaxf(t2, 0.0f)) * sigmoidf_(ip + bxv[j]) * xv[j];
                    }
                    *(u32x2*)(p5 + (size_t)row * LDP + C_AX + ch0) = (u32x2){cvt_pk_bf16(la[0], la[1]), cvt_pk_bf16(la[2], la[3])};
                    *(u32x2*)(xc + (size_t)row * 1024 + ch0) = (u32x2){cvt_pk_bf16(bb[0], bb[1]), cvt_pk_bf16(bb[2], bb[3])};
                }
            asm volatile("" ::: "memory");
        }
    }
};
struct EpiS5S {
    static constexpr bool PERM = false;
    float* sb;
    __device__ __forceinline__ void operator()(const Acc& acc, const Unit& u, int wr, int wc, int fr, int fq) const {
        const int row0 = u.aux * XROWS + u.pm * 256 + wr * 64 + fr; const int col0 = wc * 32 + 4 * fq;
#pragma unroll
        for (int ai = 0; ai < 2; ++ai)
#pragma unroll
            for (int m = 0; m < 4; ++m) { float* rowp = sb + (size_t)(row0 + ai * 128 + m * 16) * 128 + col0;
#pragma unroll
                for (int n = 0; n < 2; ++n) *(f32x4*)(rowp + n * 16) = acc[ai][0][m][n]; }
    }
};
struct EpiS5Y {
    static constexpr bool PERM = true;
    bf16_t* p5; const bf16_t* xh; const float* dsk;
    __device__ __forceinline__ void operator()(const Acc& acc, const Unit& u, int wr, int wc, int fr, int fq) const {
        const int g = u.aux; const int rr0 = u.pm * 256 + wr * 64 + fr;
        f32x4 dv[2][2];
#pragma unroll
        for (int bj = 0; bj < 2; ++bj) { const int n0 = u.pn * 256 + bj * 128 + wc * 32 + 8 * fq; const int ch = g * 16 + (n0 & 15);
            dv[bj][0] = *(const f32x4*)(dsk + ch); dv[bj][1] = *(const f32x4*)(dsk + ch + 4); }
#pragma unroll
        for (int ai = 0; ai < 2; ++ai) {
            u32x4 uw[4][2];
#pragma unroll
            for (int m = 0; m < 4; ++m)
#pragma unroll
                for (int bj = 0; bj < 2; ++bj) uw[m][bj] = *(const u32x4*)(xh + ((size_t)g * XROWS + rr0 + ai * 128 + m * 16) * XLD + u.pn * 256 + bj * 128 + wc * 32 + 8 * fq);
#pragma unroll
            for (int m = 0; m < 4; ++m) {
                const int rr = rr0 + ai * 128 + m * 16;
                if (rr < NB * NCH32) {
                    const int b = rr / NCH32, chunk = rr - b * NCH32;
#pragma unroll
                    for (int bj = 0; bj < 2; ++bj) {
                        const int n0 = u.pn * 256 + bj * 128 + wc * 32 + 8 * fq; const int i = n0 >> 4, co0 = n0 & 15;
                        const u32x4 w_ = uw[m][bj];
                        const float uv[8] = {bf_lo(w_.x), bf_hi(w_.x), bf_lo(w_.y), bf_hi(w_.y), bf_lo(w_.z), bf_hi(w_.z), bf_lo(w_.w), bf_hi(w_.w)};
                        const int ch = g * 16 + co0; float y[8];
#pragma unroll
                        for (int j = 0; j < 8; ++j) y[j] = gelu_tanh(acc[ai][bj][m][j >> 2][j & 3] + dv[bj][j >> 2][j & 3] * uv[j]);
                        u32x4 w; w.x = cvt_pk_bf16(y[0], y[1]); w.y = cvt_pk_bf16(y[2], y[3]); w.z = cvt_pk_bf16(y[4], y[5]); w.w = cvt_pk_bf16(y[6], y[7]);
                        *(u32x4*)(p5 + ((size_t)b * TP + chunk * 32 + i) * LDP + C_V + ch) = w;
                    }
                }
            }
            asm volatile("" ::: "memory");
        }
    }
};
struct EpiGlu {
    static constexpr bool PERM = true;
    bf16_t* p5; const float* bglu;
    __device__ __forceinline__ void operator()(const Acc& acc, const Unit& u, int wr, int wc, int fr, int fq) const {
        const int row0 = u.pm * 256 + wr * 64 + fr;
#pragma unroll
        for (int bj = 0; bj < 2; ++bj) {
            const int col = u.pn * 256 + bj * 128 + wc * 32 + 8 * fq;
            const f32x4 b0 = *(const f32x4*)(bglu + col), b1 = *(const f32x4*)(bglu + col + 4);
            u32x4 yw[2][4];
#pragma unroll
            for (int ai = 0; ai < 2; ++ai)
#pragma unroll
                for (int m = 0; m < 4; ++m) yw[ai][m] = *(const u32x4*)(p5 + (size_t)(row0 + ai * 128 + m * 16) * LDP + C_V + col);
#pragma unroll
            for (int ai = 0; ai < 2; ++ai)
#pragma unroll
                for (int m = 0; m < 4; ++m) {
                    const int row = row0 + ai * 128 + m * 16; const u32x4 w_ = yw[ai][m];
                    const float yv[8] = {bf_lo(w_.x), bf_hi(w_.x), bf_lo(w_.y), bf_hi(w_.y), bf_lo(w_.z), bf_hi(w_.z), bf_lo(w_.w), bf_hi(w_.w)};
                    float o[8];
#pragma unroll
                    for (int j = 0; j < 8; ++j) o[j] = yv[j] * sigmoidf_(acc[ai][bj][m][j >> 2][j & 3] + (j < 4 ? b0[j & 3] : b1[j & 3]));
                    u32x4 w; w.x = cvt_pk_bf16(o[0], o[1]); w.y = cvt_pk_bf16(o[2], o[3]); w.z = cvt_pk_bf16(o[4], o[5]); w.w = cvt_pk_bf16(o[6], o[7]);
                    *(u32x4*)(p5 + (size_t)row * LDP + C_K + col) = w;
                }
            asm volatile("" ::: "memory");
        }
    }
};
struct EpiG2 {
    static constexpr bool PERM = true;
    const bf16_t* gates; u32x4* scr; bf16_t* merged; float* part; int pieces;
    __device__ __forceinline__ void operator()(const Acc& acc, const Unit& u, int wr, int wc, int fr, int fq) const {
        const int row0 = u.pm * 256 + wr * 64 + fr; const int br = u.aux & 3, pcs = u.aux >> 2;
        unsigned soff = (unsigned)opaque_tid();
        float* pbase = part + (size_t)((u.pn * 3 + br) * pieces + (pcs - 1)) * 65536;
#pragma unroll
        for (int ai = 0; ai < 2; ++ai)
#pragma unroll
            for (int mh = 0; mh < 2; ++mh) {
                u32x2 gw[2][2]; u32x4 ps[2][2];
#pragma unroll
                for (int mm = 0; mm < 2; ++mm)
#pragma unroll
                    for (int bj = 0; bj < 2; ++bj) {
                        const int row = row0 + ai * 128 + (2 * mh + mm) * 16, col = u.pn * 256 + bj * 128 + wc * 32 + 8 * fq;
                        gw[mm][bj] = *(const u32x2*)((const unsigned char*)gates + (size_t)row * NGATE + br * 2048 + col);
                        if (br > 0 && pcs == 0) ps[mm][bj] = scr[soff + (mm * 2 + bj) * 512];
                    }
#pragma unroll
                for (int mm = 0; mm < 2; ++mm)
#pragma unroll
                    for (int bj = 0; bj < 2; ++bj) {
                        const int m = 2 * mh + mm; const int row = row0 + ai * 128 + m * 16; const int colt = bj * 128 + wc * 32 + 8 * fq, col = u.pn * 256 + colt;
                        const u32x2 g_ = gw[mm][bj]; const float k255 = 1.0f / 255.0f;
                        f32x4 v0 = acc[ai][bj][m][0], v1 = acc[ai][bj][m][1];
#pragma unroll
                        for (int j = 0; j < 4; ++j) { v0[j] *= (float)((g_.x >> (8 * j)) & 0xffu) * k255; v1[j] *= (float)((g_.y >> (8 * j)) & 0xffu) * k255; }
                        if (pcs) { float* d = pbase + (size_t)(wr * 64 + fr + ai * 128 + m * 16) * 256 + colt; *(f32x4*)d = v0; *(f32x4*)(d + 4) = v1; }
                        else {
                            if (br > 0) { const u32x4 p_ = ps[mm][bj];
                                v0[0] += bf_lo(p_.x); v0[1] += bf_hi(p_.x); v0[2] += bf_lo(p_.y); v0[3] += bf_hi(p_.y);
                                v1[0] += bf_lo(p_.z); v1[1] += bf_hi(p_.z); v1[2] += bf_lo(p_.w); v1[3] += bf_hi(p_.w); }
                            u32x4 w; w.x = cvt_pk_bf16(v0[0], v0[1]); w.y = cvt_pk_bf16(v0[2], v0[3]); w.z = cvt_pk_bf16(v1[0], v1[1]); w.w = cvt_pk_bf16(v1[2], v1[3]);
                            if (br < 2) scr[soff + (mm * 2 + bj) * 512] = w;
                            else *(u32x4*)(merged + (size_t)row * D + col) = w;
                        }
                    }
                soff += 2048u; asm volatile("" : "+v"(soff) :: "memory");
            }
    }
};
__device__ __forceinline__ void g2_tail_reduce(const float* part, int pieces, bf16_t* merged) {
    const int tid = opaque_tid(); const int pn = (4 * tid) >> 8, cc = (4 * tid) & 255;
    for (int R = blockIdx.x; R < 256; R += gridDim.x) {
        f32x4 a = (f32x4){0.f, 0.f, 0.f, 0.f};
        for (int k = 0; k < 3 * pieces; ++k) a += *(const f32x4*)(part + (size_t)(pn * 3 * pieces + k) * 65536 + (size_t)R * 256 + cc);
        *(u32x2*)(merged + (size_t)(MP - 256 + R) * D + 4 * tid) = (u32x2){cvt_pk_bf16(a.x, a.y), cvt_pk_bf16(a.z, a.w)};
    }
}
struct EpiMix {
    static constexpr bool PERM = true;
    bf16_t* C; int ldc; float* part; int pieces;
    __device__ __forceinline__ void operator()(const Acc& acc, const Unit& u, int wr, int wc, int fr, int fq) const {
        const int r0 = wr * 64 + fr;
#pragma unroll
        for (int ai = 0; ai < 2; ++ai)
#pragma unroll
            for (int m = 0; m < 4; ++m) { const int r = r0 + ai * 128 + m * 16;
#pragma unroll
                for (int bj = 0; bj < 2; ++bj) { const int colt = bj * 128 + wc * 32 + 8 * fq; const f32x4 v0 = acc[ai][bj][m][0], v1 = acc[ai][bj][m][1];
                    if (u.aux == 0) { u32x4 w; w.x = cvt_pk_bf16(v0[0], v0[1]); w.y = cvt_pk_bf16(v0[2], v0[3]); w.z = cvt_pk_bf16(v1[0], v1[1]); w.w = cvt_pk_bf16(v1[2], v1[3]);
                        *(u32x4*)(C + (size_t)(u.pm * 256 + r) * ldc + u.pn * 256 + colt) = w; }
                    else { float* d = part + (size_t)(u.pn * pieces + (u.aux - 1)) * 65536 + (size_t)r * 256 + colt; *(f32x4*)d = v0; *(f32x4*)(d + 4) = v1; } }
                asm volatile("" ::: "memory"); }
    }
};
struct EpiSwiglu {
    static constexpr bool PERM = true;
    bf16_t* hid;
    __device__ __forceinline__ void operator()(const Acc& acc, const Unit& u, int wr, int wc, int fr, int fq) const {
        const int row0 = u.pm * 256 + wr * 64 + fr; const int col = u.pn * 128 + wc * 32 + 8 * fq;
#pragma unroll
        for (int ai = 0; ai < 2; ++ai)
#pragma unroll
            for (int m = 0; m < 4; ++m) {
                float o[8];
#pragma unroll
                for (int j = 0; j < 8; ++j) { const float g = acc[ai][0][m][j >> 2][j & 3], up = acc[ai][1][m][j >> 2][j & 3]; o[j] = g * sigmoidf_(g) * up; }
                u32x4 w; w.x = cvt_pk_bf16(o[0], o[1]); w.y = cvt_pk_bf16(o[2], o[3]); w.z = cvt_pk_bf16(o[4], o[5]); w.w = cvt_pk_bf16(o[6], o[7]);
                *(u32x4*)(hid + (size_t)(row0 + ai * 128 + m * 16) * DFF + col) = w;
            }
    }
};
}

template <int MAPMODE>
__device__ __forceinline__ void transpose_item(const float* W, int K, int N, bf16_t* WT, int item, int sub, int lane) {
    const int nblk = N / 256, kb = item / nblk, nb = item - kb * nblk, n = 256 * nb + 4 * lane;
    int nn = n;
    if (MAPMODE == 1) { if (nn < DFF) nn = 256 * (nn >> 7) + (nn & 127); else { const int q = nn - DFF; nn = 256 * (q >> 7) + 128 + (q & 127); } }
    {
        const int k0 = 64 * kb + 16 * sub;
        f32x4 r[16];
#pragma unroll
        for (int e = 0; e < 16; ++e) r[e] = *(const f32x4*)(W + (size_t)(k0 + e) * N + n);
#pragma unroll
        for (int j = 0; j < 4; ++j) {
            u32x4 o0, o1;
            o0.x = cvt_pk_bf16(r[0][j], r[1][j]); o0.y = cvt_pk_bf16(r[2][j], r[3][j]); o0.z = cvt_pk_bf16(r[4][j], r[5][j]); o0.w = cvt_pk_bf16(r[6][j], r[7][j]);
            o1.x = cvt_pk_bf16(r[8][j], r[9][j]); o1.y = cvt_pk_bf16(r[10][j], r[11][j]); o1.z = cvt_pk_bf16(r[12][j], r[13][j]); o1.w = cvt_pk_bf16(r[14][j], r[15][j]);
            bf16_t* d = WT + (size_t)(nn + j) * K + k0;
            *(u32x4*)d = o0; *(u32x4*)(d + 8) = o1;
        }
    }
}

__device__ __forceinline__ void s5_gen_task(LAS unsigned char* lds, int g, int qd, const float* lam_re, const float* lam_im, const float* b_re, const float* b_im,
                                            const float* c_re, const float* c_im, const float* log_step, bf16_t* TPm, bf16_t* W1) {
    LAS float* pwr = (LAS float*)lds;
    LAS float* pwi = pwr + 33 * 64;
    LAS float* bbr = pwi + 33 * 64;
    LAS float* bbi = bbr + 1024;
    LAS float* cr = bbi + 1024;
    LAS float* ci = cr + 1024;
    LAS float* Kt = ci + 1024;
    const int tid = opaque_tid();
    __syncthreads();
    {
        const int p = tid & 63, ds = tid >> 6; const float lr = lam_re[g * 64 + p], li = lam_im[g * 64 + p], step = expf(log_step[g]);
        for (int d = ds; d <= 32; d += 8) { const float mag = expf((float)d * lr * step); float s_, c_; sincosf((float)d * li * step, &s_, &c_); pwr[d * 64 + p] = mag * c_; pwi[d * 64 + p] = mag * s_; }
        if (ds == 0) {
            const float mag = expf(lr * step); float s_, c_; sincosf(li * step, &s_, &c_); const float ar = mag * c_, aim = mag * s_;
            const float den = lr * lr + li * li; const float cre = ((ar - 1.0f) * lr + aim * li) / den, cim = (aim * lr - (ar - 1.0f) * li) / den;
            for (int cc = 0; cc < 16; ++cc) { const float br = b_re[((size_t)g * 64 + p) * 16 + cc], bi = b_im[((size_t)g * 64 + p) * 16 + cc];
                bbr[p * 16 + cc] = cre * br - cim * bi; bbi[p * 16 + cc] = cre * bi + cim * br; }
        }
    }
    for (int i = tid; i < 1024; i += 512) { cr[i] = c_re[(size_t)g * 1024 + i]; ci[i] = c_im[(size_t)g * 1024 + i]; }
    __syncthreads();
    for (int e = tid; e < 2048; e += 512) {
        const int d = e >> 6, col = (e >> 4) & 3, co = 4 * qd + col, cin = e & 15; float a = 0.f;
        for (int p = 0; p < 64; ++p) { const float pr = pwr[d * 64 + p], pi = pwi[d * 64 + p], br = bbr[p * 16 + cin], bi = bbi[p * 16 + cin];
            const float er = pr * br - pi * bi, ei = pr * bi + pi * br; a += cr[co * 64 + p] * er - ci[co * 64 + p] * ei; }
        Kt[e] = a;
    }
    __syncthreads();
    bf16_t* tp = TPm + (size_t)g * 512 * XLD;
    for (int q = tid; q < 128 * 80; q += 512) {
        const int nl = q / 80, kc = q - nl * 80, k0 = kc * 8; const int i = nl >> 2, col = nl & 3, co = 4 * qd + col, n = i * 16 + co; float v[8];
        if (k0 < 512) { const int j = k0 >> 4, cin0 = k0 & 15;
#pragma unroll
            for (int e = 0; e < 8; ++e) v[e] = (j <= i) ? Kt[(i - j) * 64 + col * 16 + cin0 + e] : 0.f;
        } else { const int p0 = (k0 - 512) >> 1;
#pragma unroll
            for (int e = 0; e < 4; ++e) { const int p = p0 + e; const float pr = pwr[(i + 1) * 64 + p], pi = pwi[(i + 1) * 64 + p], c_r = cr[co * 64 + p], c_i = ci[co * 64 + p];
                v[2 * e] = c_r * pr - c_i * pi; v[2 * e + 1] = -(c_r * pi + c_i * pr); }
        }
        u32x4 w; w.x = cvt_pk_bf16(v[0], v[1]); w.y = cvt_pk_bf16(v[2], v[3]); w.z = cvt_pk_bf16(v[4], v[5]); w.w = cvt_pk_bf16(v[6], v[7]);
        *(u32x4*)(tp + (size_t)n * XLD + k0) = w;
    }
    bf16_t* w1 = W1 + (size_t)g * 128 * 512;
    for (int q = tid; q < 32 * 64; q += 512) {
        const int n = 32 * qd + (q >> 6), kc = q & 63, k0 = kc * 8; const int p = n >> 1, r = n & 1; const int j = k0 >> 4, cin0 = k0 & 15; float v[8];
        const float pr = pwr[(31 - j) * 64 + p], pi = pwi[(31 - j) * 64 + p];
#pragma unroll
        for (int e = 0; e < 8; ++e) { const float br = bbr[p * 16 + cin0 + e], bi = bbi[p * 16 + cin0 + e]; v[e] = r ? (pr * bi + pi * br) : (pr * br - pi * bi); }
        u32x4 w; w.x = cvt_pk_bf16(v[0], v[1]); w.y = cvt_pk_bf16(v[2], v[3]); w.z = cvt_pk_bf16(v[4], v[5]); w.w = cvt_pk_bf16(v[6], v[7]);
        *(u32x4*)(w1 + (size_t)n * 512 + k0) = w;
    }
    __syncthreads();
}

#define GASF const __attribute__((address_space(1))) float
__device__ __forceinline__ void phase_norm(const Params& P, int mode, const bf16_t* src, const float* w_add, const float* w_norm, bf16_t* hbuf, bf16_t* xsb, const float* part, int pieces) {
    const int tid_ = opaque_tid(); const int lane = tid_ & 63, wave = tid_ >> 6; const int gw = blockIdx.x * 8 + wave, NGW = gridDim.x * 8;
    for (int m = gw; m < MP; m += NGW) {
        const int b = m / TP, tp = m - b * TP;
        u32x2* hrow = (u32x2*)(hbuf + (size_t)m * D) + lane;
        if (tp < PADT) { if (mode != 2) {
#pragma unroll
                for (int j = 0; j < 8; ++j) hrow[64 * j] = (u32x2){0u, 0u}; }
            continue; }
        if (mode == 2 && tp < 64) continue;
        f32x4 v[8];
        if (mode == 0 || mode == 3) {
            GASF* s0 = (tp < 64) ? (GASF*)P.in[I_META] + (size_t)(tp - PADT) * D : (GASF*)P.in[I_X] + ((size_t)b * SEQ + (tp - 64)) * D;
#pragma unroll
            for (int j = 0; j < 8; ++j) v[j] = ((const __attribute__((address_space(1))) f32x4*)s0)[lane + 64 * j];
        } else {
#pragma unroll
            for (int j = 0; j < 8; ++j) { const u32x2 w = ((const u32x2*)(xsb + (size_t)m * D))[lane + 64 * j]; v[j] = (f32x4){bf_lo(w.x), bf_hi(w.x), bf_lo(w.y), bf_hi(w.y)}; }
        }
        if (mode != 0) {
            f32x4 s[8]; float ss = 0.f;
            if (m < MP - 256) {
#pragma unroll
                for (int j = 0; j < 8; ++j) { const u32x2 w = ((const u32x2*)(src + (size_t)m * D))[lane + 64 * j]; s[j] = (f32x4){bf_lo(w.x), bf_hi(w.x), bf_lo(w.y), bf_hi(w.y)}; }
            } else {
#pragma unroll
                for (int j = 0; j < 8; ++j) s[j] = (f32x4){0.f, 0.f, 0.f, 0.f};
#pragma unroll 2
                for (int pc = 0; pc < pieces; ++pc) {
#pragma unroll
                    for (int j = 0; j < 8; ++j) s[j] += ((const f32x4*)(part + ((size_t)(j * pieces + pc) * 256 + (m - (MP - 256))) * 256))[lane];
                }
            }
#pragma unroll
            for (int j = 0; j < 8; ++j) ss += (s[j].x * s[j].x + s[j].y * s[j].y) + (s[j].z * s[j].z + s[j].w * s[j].w);
            const float r = rsqrtf(wave_sum(ss) * (1.0f / D) + 1e-6f);
#pragma unroll
            for (int j = 0; j < 8; ++j) { const f32x4 w = ((const f32x4*)w_add)[lane + 64 * j]; v[j] += s[j] * r * w; }
            if (mode == 2) {
                __attribute__((address_space(1))) f32x4* o = (__attribute__((address_space(1))) f32x4*)((__attribute__((address_space(1))) float*)P.out + ((size_t)b * SEQ + (tp - 64)) * D);
#pragma unroll
                for (int j = 0; j < 8; ++j) o[lane + 64 * j] = v[j];
                continue;
            }
#pragma unroll
            for (int j = 0; j < 8; ++j) ((u32x2*)(xsb + (size_t)m * D))[lane + 64 * j] = (u32x2){cvt_pk_bf16(v[j].x, v[j].y), cvt_pk_bf16(v[j].z, v[j].w)};
        }
        float ss = 0.f;
#pragma unroll
        for (int j = 0; j < 8; ++j) ss += (v[j].x * v[j].x + v[j].y * v[j].y) + (v[j].z * v[j].z + v[j].w * v[j].w);
        const float r = rsqrtf(wave_sum(ss) * (1.0f / D) + 1e-6f);
#pragma unroll
        for (int j = 0; j < 8; ++j) { const f32x4 w = ((const f32x4*)w_norm)[lane + 64 * j]; const f32x4 o = v[j] * r * w;
            hrow[64 * j] = (u32x2){cvt_pk_bf16(o.x, o.y), cvt_pk_bf16(o.z, o.w)}; }
    }
}

__device__ __forceinline__ void phase_prep(LAS unsigned char* lds, const bf16_t* p5, bf16_t* xc, bf16_t* vt, const float* cw, const float* cb) {
    const int tid = opaque_tid(); const int gt = blockIdx.x * 512 + tid, NGT = gridDim.x * 512;
    for (int it = gt; it < MP * 128; it += NGT) {
        const int m = it >> 7, c0 = (it & 127) * 8; float o[8];
#pragma unroll
        for (int j = 0; j < 8; ++j) o[j] = cb[c0 + j];
#pragma unroll
        for (int k = 0; k < 4; ++k) { const int mm = m - 3 + k; if (mm >= 0) {
                const u32x4 a = *(const u32x4*)(p5 + (size_t)mm * LDP + C_AX + c0);
                const float av[8] = {bf_lo(a.x), bf_hi(a.x), bf_lo(a.y), bf_hi(a.y), bf_lo(a.z), bf_hi(a.z), bf_lo(a.w), bf_hi(a.w)};
#pragma unroll
                for (int j = 0; j < 8; ++j) o[j] += cw[k * 1024 + c0 + j] * av[j]; } }
        u32x4 w; w.x = cvt_pk_bf16(o[0], o[1]); w.y = cvt_pk_bf16(o[2], o[3]); w.z = cvt_pk_bf16(o[4], o[5]); w.w = cvt_pk_bf16(o[6], o[7]);
        *(u32x4*)(xc + (size_t)m * 1024 + c0) = w;
    }
    LAS bf16_t* tl = (LAS bf16_t*)lds;
    for (int it = blockIdx.x; it < 32 * 65; it += gridDim.x) {
        const int bh = it / 65, tb = it - bh * 65, b = bh >> 3, h = bh & 7;
        __syncthreads();
#pragma unroll
        for (int i = 0; i < 2; ++i) { const int id = tid + 512 * i, row = id >> 4, c16 = id & 15;
            const u32x4 a = *(const u32x4*)(p5 + ((size_t)b * TP + tb * 64 + row) * LDP + C_V + h * 128 + c16 * 8);
            LAS unsigned* d = (LAS unsigned*)(tl + row * 130 + c16 * 8); d[0] = a.x; d[1] = a.y; d[2] = a.z; d[3] = a.w; }
        __syncthreads();
#pragma unroll
        for (int i = 0; i < 2; ++i) { const int id = tid + 512 * i, dv = id >> 3, c8 = id & 7; unsigned short e[8];
#pragma unroll
            for (int j = 0; j < 8; ++j) e[j] = tl[(c8 * 8 + j) * 130 + dv];
            u32x4 w; w.x = e[0] | ((unsigned)e[1] << 16); w.y = e[2] | ((unsigned)e[3] << 16); w.z = e[4] | ((unsigned)e[5] << 16); w.w = e[6] | ((unsigned)e[7] << 16);
            *(u32x4*)(vt + ((size_t)bh * 128 + dv) * TP + tb * 64 + c8 * 8) = w; }
    }
    __syncthreads();
}

__device__ __forceinline__ void lru_scan1(const bf16_t* p5, const bf16_t* bbuf, float* agg) {
    const int gt = blockIdx.x * 512 + opaque_tid(), NGT = gridDim.x * 512;
    for (int it = gt; it < NB * NCH64 * 512; it += NGT) {
        const int cp = it & 511, bc = it >> 9; const int b = bc / NCH64, c = bc - b * NCH64; const size_t m0 = (size_t)b * TP + c * 64;
        float s0 = 0.f, s1 = 0.f, h0 = 0.f, h1 = 0.f;
        for (int t0 = 0; t0 < 64; t0 += 16) {
            unsigned lw[16], bw[16];
#pragma unroll
            for (int k = 0; k < 16; ++k) { lw[k] = *(const unsigned*)(p5 + (m0 + t0 + k) * LDP + C_AX + 2 * cp); bw[k] = *(const unsigned*)(bbuf + (m0 + t0 + k) * 1024 + 2 * cp); }
#pragma unroll
            for (int k = 0; k < 16; ++k) { const float l0 = bf_lo(lw[k]), l1 = bf_hi(lw[k]); s0 += l0; s1 += l1; h0 = __expf(l0) * h0 + bf_lo(bw[k]); h1 = __expf(l1) * h1 + bf_hi(bw[k]); }
        }
        *(f32x4*)(agg + ((size_t)bc * 512 + cp) * 4) = (f32x4){s0, h0, s1, h1};
    }
}
__device__ __forceinline__ void lru_scan2(bf16_t* p5, const bf16_t* bbuf, const float* agg) {
    const int gt = blockIdx.x * 512 + opaque_tid(), NGT = gridDim.x * 512;
    for (int it = gt; it < NB * NCH64 * 512; it += NGT) {
        const int cp = it & 511, bc = it >> 9; const int b = bc / NCH64, c = bc - b * NCH64; const size_t m0 = (size_t)b * TP + c * 64;
        float h0 = 0.f, h1 = 0.f;
        for (int cc0 = 0; cc0 < c; cc0 += 8) {
            f32x4 a[8];
#pragma unroll
            for (int k = 0; k < 8; ++k) a[k] = (cc0 + k < c) ? *(const f32x4*)(agg + ((size_t)(b * NCH64 + cc0 + k) * 512 + cp) * 4) : (f32x4){0.f, 0.f, 0.f, 0.f};
#pragma unroll
            for (int k = 0; k < 8; ++k) { h0 = __expf(a[k].x) * h0 + a[k].y; h1 = __expf(a[k].z) * h1 + a[k].w; }
        }
        for (int t0 = 0; t0 < 64; t0 += 8) {
            unsigned lw[8], bw[8], gw[8];
#pragma unroll
            for (int k = 0; k < 8; ++k) { lw[k] = *(const unsigned*)(p5 + (m0 + t0 + k) * LDP + C_AX + 2 * cp); bw[k] = *(const unsigned*)(bbuf + (m0 + t0 + k) * 1024 + 2 * cp);
                gw[k] = *(const unsigned*)(p5 + (m0 + t0 + k) * LDP + C_AG + 2 * cp); }
#pragma unroll
            for (int k = 0; k < 8; ++k) { h0 = __expf(bf_lo(lw[k])) * h0 + bf_lo(bw[k]); h1 = __expf(bf_hi(lw[k])) * h1 + bf_hi(bw[k]);
                gw[k] = cvt_pk_bf16(h0 * gelu_tanh(bf_lo(gw[k])), h1 * gelu_tanh(bf_hi(gw[k]))); }
#pragma unroll
            for (int k = 0; k < 8; ++k) *(unsigned*)(p5 + (m0 + t0 + k) * LDP + C_AG + 2 * cp) = gw[k];
        }
    }
}
__device__ __forceinline__ void s5_carry(bf16_t* xh, const float* sb, const float* lam_re, const float* lam_im, const float* log_step) {
    const int gt = blockIdx.x * 512 + opaque_tid(), NGT = gridDim.x * 512;
    for (int it = gt; it < NB * 64 * 64; it += NGT) {
        const int p = it & 63, g = (it >> 6) & 63, b = it >> 12;
        const float lr = lam_re[g * 64 + p], li = lam_im[g * 64 + p], step = expf(log_step[g]);
        const float mag = expf(32.0f * lr * step); float s, c; sincosf(32.0f * li * step, &s, &c); const float ar = mag * c, ai = mag * s;
        float hr = 0.f, hi = 0.f;
        for (int ch0 = 0; ch0 < NCH32; ch0 += 26) {
            const size_t row0 = (size_t)g * XROWS + b * NCH32 + ch0; f32x2 sv[26];
#pragma unroll
            for (int k = 0; k < 26; ++k) sv[k] = *(const f32x2*)(sb + (row0 + k) * 128 + 2 * p);
#pragma unroll
            for (int k = 0; k < 26; ++k) {
                *(unsigned*)(xh + (row0 + k) * XLD + 512 + 2 * p) = cvt_pk_bf16(hr, hi);
                const float nr = ar * hr - ai * hi + sv[k].x, ni = ar * hi + ai * hr + sv[k].y; hr = nr; hi = ni; }
        }
    }
}

__device__ __forceinline__ float rows4_max(float v) {
    unsigned a = __float_as_uint(v); auto r = __builtin_amdgcn_permlane16_swap(a, a, false, false); v = fmaxf(__uint_as_float(r[0]), __uint_as_float(r[1]));
    a = __float_as_uint(v); auto r2 = __builtin_amdgcn_permlane32_swap(a, a, false, false); return fmaxf(__uint_as_float(r2[0]), __uint_as_float(r2[1])); }
__device__ __forceinline__ float rows4_sum(float v) {
    unsigned a = __float_as_uint(v); auto r = __builtin_amdgcn_permlane16_swap(a, a, false, false); v = __uint_as_float(r[0]) + __uint_as_float(r[1]);
    a = __float_as_uint(v); auto r2 = __builtin_amdgcn_permlane32_swap(a, a, false, false); return __uint_as_float(r2[0]) + __uint_as_float(r2[1]); }
constexpr int KPITCH = 272, VPITCH = 144, KBYTES = 64 * KPITCH, VBYTES = 128 * VPITCH;
__device__ __forceinline__ void attn_phase(LAS unsigned char* lds, bf16_t* p5, const bf16_t* vt, const float* relb, const float* dalam, const float* subln, float lam_init, int ocol) {
    const int tid = opaque_tid(), lane = tid & 63, wave = __builtin_amdgcn_readfirstlane(tid >> 6), lq = lane & 15, g4 = lane >> 4;
    const int cc = wave & 1, rgi = wave >> 1;
    LAS float* btab = (LAS float*)(lds + 2 * KBYTES + 2 * VBYTES);
    float lam;
    { float s1 = 0.f, s2 = 0.f; for (int i = 0; i < 64; ++i) { s1 += dalam[i] * dalam[64 + i]; s2 += dalam[128 + i] * dalam[192 + i]; } lam = expf(s1) - expf(s2) + lam_init; }
    const int c = blockIdx.x, G = gridDim.x;
    const float sc2 = 0.125f * LOG2E;
    for (int r = 0;; ++r) {
        const int idx = (r & 1) ? r * G + (G - 1 - c) : r * G + c;
        if (r * G >= 33 * 32) break;
        if (idx >= 33 * 32) continue;
        const int qt = 32 - idx / 32, bh = idx & 31, b = bh >> 3, h = bh & 7;
        const int njt = (2 * qt + 2) < 65 ? (2 * qt + 2) : 65;
        const int qrow0 = qt * 128 + rgi * 32;
        __syncthreads();
        if (tid < 128) { const int d = tid; int bk = d; if (d >= 16) { bk = 16 + (int)(logf((float)d * (1.0f / 16.0f)) * (16.0f / logf(8.0f))); if (bk > 31) bk = 31; } btab[d] = relb[bk * 8 + h] * LOG2E; }
        const float bfar = relb[31 * 8 + h] * LOG2E;
        bf16x8 qf[2][2];
#pragma unroll
        for (int rg = 0; rg < 2; ++rg) { const int q = qrow0 + 16 * rg + lq, qc = q < TP ? q : TP - 1;
#pragma unroll
            for (int s = 0; s < 2; ++s) qf[rg][s] = *(const bf16x8*)(p5 + ((size_t)b * TP + qc) * LDP + C_Q + h * 128 + cc * 64 + s * 32 + 8 * g4); }
        f32x4 O[2][8]; float mrow[2], lrow[2];
#pragma unroll
        for (int rg = 0; rg < 2; ++rg) { mrow[rg] = -INFINITY; lrow[rg] = 0.f;
#pragma unroll
            for (int k = 0; k < 8; ++k) O[rg][k] = (f32x4){0.f, 0.f, 0.f, 0.f}; }
        u32x4 kreg[2], vreg[2];
        const bf16_t* kbase = p5 + (size_t)b * TP * LDP + C_K + h * 128; const bf16_t* vbase = vt + (size_t)bh * 128 * TP;
#define ATT_LOAD(j) do { _Pragma("unroll") for (int i = 0; i < 2; ++i) { const int id = tid + 512 * i; \
            kreg[i] = *(const u32x4*)(kbase + (size_t)((j) * 64 + (id >> 4)) * LDP + (id & 15) * 8); \
            vreg[i] = *(const u32x4*)(vbase + (size_t)(id >> 3) * TP + (j) * 64 + (id & 7) * 8); } } while (0)
#define ATT_STORE(buf) do { _Pragma("unroll") for (int i = 0; i < 2; ++i) { const int id = tid + 512 * i; \
            *(LAS u32x4*)(lds + (buf) * KBYTES + (id >> 4) * KPITCH + (id & 15) * 16) = kreg[i]; \
            *(LAS u32x4*)(lds + 2 * KBYTES + (buf) * VBYTES + (id >> 3) * VPITCH + (id & 7) * 16) = vreg[i]; } } while (0)
        ATT_LOAD(0); ATT_STORE(0); __syncthreads();
        for (int j = 0; j < njt; ++j) {
            if (j + 1 < njt) ATT_LOAD(j + 1);
            if (j * 64 <= qrow0 + 31) {
                const LAS unsigned char* kb_ = lds + (j & 1) * KBYTES; const LAS unsigned char* vb_ = lds + 2 * KBYTES + (j & 1) * VBYTES;
                bf16x8 kf[4][2];
#pragma unroll
                for (int kb = 0; kb < 4; ++kb)
#pragma unroll
                    for (int s = 0; s < 2; ++s) kf[kb][s] = *(const LAS bf16x8*)(kb_ + (16 * kb + lq) * KPITCH + (cc * 64 + s * 32 + 8 * g4) * 2);
                __builtin_amdgcn_sched_barrier(0);
                f32x4 st[2][4];
#pragma unroll
                for (int kb = 0; kb < 4; ++kb)
#pragma unroll
                    for (int rg = 0; rg < 2; ++rg) { f32x4 a = (f32x4){0.f, 0.f, 0.f, 0.f};
#pragma unroll
                        for (int s = 0; s < 2; ++s) a = __builtin_amdgcn_mfma_f32_16x16x32_bf16(kf[kb][s], qf[rg][s], a, 0, 0, 0);
                        st[rg][kb] = a; }
                __builtin_amdgcn_sched_barrier(0);
#define ATT_VLOAD(dst, k0, nk) _Pragma("unroll") for (int k = 0; k < (nk); ++k) _Pragma("unroll") for (int s = 0; s < 2; ++s) { \
                    const LAS unsigned char* vp = vb_ + (16 * (k + (k0)) + lq) * VPITCH + (32 * s + 4 * g4) * 2; dst[k][s][0] = *(const LAS u32x2*)vp; dst[k][s][1] = *(const LAS u32x2*)(vp + 32); }
#define ATT_PV(src, k0, nk) _Pragma("unroll") for (int k = 0; k < (nk); ++k) _Pragma("unroll") for (int s = 0; s < 2; ++s) { \
                    const bf16x8 vf = __builtin_bit_cast(bf16x8, (u32x4){src[k][s][0].x, src[k][s][0].y, src[k][s][1].x, src[k][s][1].y}); \
                    O[0][k + (k0)] = __builtin_amdgcn_mfma_f32_16x16x32_bf16(vf, pk[0][s], O[0][k + (k0)], 0, 0, 0); \
                    O[1][k + (k0)] = __builtin_amdgcn_mfma_f32_16x16x32_bf16(vf, pk[1][s], O[1][k + (k0)], 0, 0, 0); }
                u32x2 va[1][2][2];
                ATT_VLOAD(va, 0, 1)
                __builtin_amdgcn_sched_barrier(0);
                const bool far = (j >= 1) && (j * 64 + 63 + 113 <= qrow0);
                bf16x8 pk[2][2];
#pragma unroll
                for (int rg = 0; rg < 2; ++rg) {
                    float rmax = -INFINITY, msafe, alpha;
                    if (far) {
#pragma unroll
                        for (int kb = 0; kb < 4; ++kb)
#pragma unroll
                            for (int i = 0; i < 4; ++i) rmax = fmaxf(rmax, st[rg][kb][i]);
                        rmax = rows4_max(rmax);
                        const float mnew = fmaxf(mrow[rg], rmax * sc2 + bfar); msafe = mnew;
                        alpha = __builtin_amdgcn_exp2f(mrow[rg] - msafe); mrow[rg] = mnew;
                        const float off = bfar - msafe;
#pragma unroll
                        for (int kb = 0; kb < 4; ++kb)
#pragma unroll
                            for (int i = 0; i < 4; ++i) st[rg][kb][i] = __builtin_amdgcn_exp2f(st[rg][kb][i] * sc2 + off);
                    } else {
                        const int q = qrow0 + 16 * rg + lq;
#pragma unroll
                        for (int kb = 0; kb < 4; ++kb)
#pragma unroll
                            for (int i = 0; i < 4; ++i) { float v = st[rg][kb][i] * sc2;
                                const int kp = j * 64 + 16 * kb + 4 * g4 + i; const int dist = q - kp;
                                const float bv = (dist >= 0 && dist < 128) ? btab[dist] : bfar;
                                v = (kp >= PADT && dist >= 0) ? v + bv : -INFINITY;
                                st[rg][kb][i] = v; rmax = fmaxf(rmax, v); }
                        rmax = rows4_max(rmax);
                        const float mnew = fmaxf(mrow[rg], rmax); msafe = (mnew == -INFINITY) ? 0.f : mnew;
                        alpha = __builtin_amdgcn_exp2f(mrow[rg] - msafe); mrow[rg] = mnew;
#pragma unroll
                        for (int kb = 0; kb < 4; ++kb)
#pragma unroll
                            for (int i = 0; i < 4; ++i) st[rg][kb][i] = __builtin_amdgcn_exp2f(st[rg][kb][i] - msafe);
                    }
                    float rs = 0.f;
#pragma unroll
                    for (int kb = 0; kb < 4; ++kb) rs += (st[rg][kb][0] + st[rg][kb][1]) + (st[rg][kb][2] + st[rg][kb][3]);
                    lrow[rg] = lrow[rg] * alpha + rs;
                    if (__builtin_amdgcn_ballot_w64(alpha != 1.0f) != 0ull) {
#pragma unroll
                        for (int k = 0; k < 8; ++k) O[rg][k] *= alpha; }
#pragma unroll
                    for (int s = 0; s < 2; ++s) { u32x4 w; w.x = cvt_pk_bf16(st[rg][2 * s][0], st[rg][2 * s][1]); w.y = cvt_pk_bf16(st[rg][2 * s][2], st[rg][2 * s][3]);
                        w.z = cvt_pk_bf16(st[rg][2 * s + 1][0], st[rg][2 * s + 1][1]); w.w = cvt_pk_bf16(st[rg][2 * s + 1][2], st[rg][2 * s + 1][3]);
                        pk[rg][s] = __builtin_bit_cast(bf16x8, w); }
                }
                __builtin_amdgcn_sched_barrier(0);
                u32x2 vc[3][2][2];
                ATT_VLOAD(vc, 1, 3)
                __builtin_amdgcn_sched_barrier(0);
                ATT_PV(va, 0, 1)
                __builtin_amdgcn_sched_barrier(0);
                u32x2 vd[2][2][2];
                ATT_VLOAD(vd, 4, 2)
                __builtin_amdgcn_sched_barrier(0);
                ATT_PV(vc, 1, 3)
                __builtin_amdgcn_sched_barrier(0);
                u32x2 ve[2][2][2];
                ATT_VLOAD(ve, 6, 2)
                __builtin_amdgcn_sched_barrier(0);
                ATT_PV(vd, 4, 2)
                __builtin_amdgcn_sched_barrier(0);
                ATT_PV(ve, 6, 2)
#undef ATT_VLOAD
#undef ATT_PV
            }
            if (j + 1 < njt) ATT_STORE((j + 1) & 1);
            __syncthreads();
        }
#undef ATT_LOAD
#undef ATT_STORE
        LAS f32x4* xch = (LAS f32x4*)lds + (size_t)rgi * 2 * 8 * 64 + lane;
#pragma unroll
        for (int rg = 0; rg < 2; ++rg) { const float l_ = rows4_sum(lrow[rg]); const float f = l_ > 0.f ? (cc ? lam : 1.0f) / l_ : 0.f;
#pragma unroll
            for (int k = 0; k < 8; ++k) { O[rg][k] *= f; if (cc) xch[(rg * 8 + k) * 64] = O[rg][k]; } }
        __syncthreads();
        if (cc == 0) {
#pragma unroll
            for (int rg = 0; rg < 2; ++rg) { const int q = qrow0 + 16 * rg + lq; float ss = 0.f;
#pragma unroll
                for (int k = 0; k < 8; ++k) { O[rg][k] -= xch[(rg * 8 + k) * 64]; ss += (O[rg][k].x * O[rg][k].x + O[rg][k].y * O[rg][k].y) + (O[rg][k].z * O[rg][k].z + O[rg][k].w * O[rg][k].w); }
                ss = rows4_sum(ss);
                const float rn = rsqrtf(ss * (1.0f / 128.0f) + 1e-5f) * (1.0f - lam_init);
                if (q < TP) {
#pragma unroll
                    for (int k = 0; k < 8; ++k) { const f32x4 w = *(const f32x4*)(subln + 16 * k + 4 * g4); const f32x4 o = O[rg][k] * rn * w;
                        *(u32x2*)(p5 + ((size_t)b * TP + q) * LDP + ocol + h * 128 + 16 * k + 4 * g4) = (u32x2){cvt_pk_bf16(o.x, o.y), cvt_pk_bf16(o.z, o.w)}; }
                }
            }
        }
    }
    __syncthreads();
}

#define XB_TMO      128
#define XB_XCNT(j)  (256  + 64 * (j))
#define XB_XSUB(j)  (1280 + 64 * (j))
#define XB_XGEN(j)  (2304 + 64 * (j))
#define XB_TOP      3328
#define XB_TOPGEN   3392
#define XCD_BAR_WORDS 3456
#define XB_SPIN_CAP (1u << 20)
__device__ __forceinline__ unsigned xb_ld(unsigned* p)              { return __hip_atomic_load(p, __ATOMIC_RELAXED, __HIP_MEMORY_SCOPE_AGENT); }
__device__ __forceinline__ unsigned xb_add(unsigned* p, unsigned v) { return __hip_atomic_fetch_add(p, v, __ATOMIC_RELAXED, __HIP_MEMORY_SCOPE_AGENT); }
__device__ __forceinline__ unsigned xb_xcc_id() { return (unsigned)__builtin_amdgcn_s_getreg((3 << 11) | 20) & 0xFu; }
#define XB_SPIN(cond, bar) do { unsigned _sp = 0; while (cond) { __builtin_amdgcn_s_sleep(1); \
    if ((++_sp & 255u) == 0u) { if (xb_ld(&(bar)[XB_TMO])) break; if (_sp > XB_SPIN_CAP) { atomicAdd(&(bar)[XB_TMO], 1u); break; } } } } while (0)
struct XcdBarrier { unsigned* bar; unsigned x; volatile LAS unsigned* st; };
__device__ __forceinline__ XcdBarrier xcd_barrier_post(unsigned* bar, volatile LAS unsigned* st) {
    XcdBarrier b; b.bar = bar; b.x = xb_xcc_id(); b.st = st;
    if (threadIdx.x == 0) (void)xb_add(&bar[XB_XCNT(b.x)], 1u);
    return b;
}
__device__ __forceinline__ void xcd_barrier_complete(unsigned* bar, unsigned x, unsigned& nloc, unsigned& nx) {
    const unsigned G = gridDim.x * gridDim.y * gridDim.z;
    unsigned sum, cnt, mine, sp = 0u;
    for (;;) {
        sum = 0u; cnt = 0u; mine = 0u;
#pragma unroll
        for (unsigned j = 0; j < 16; ++j) { const unsigned c = xb_ld(&bar[XB_XCNT(j)]); sum += c; cnt += (c > 0u) ? 1u : 0u; mine = (j == x) ? c : mine; }
        if (sum == G) break;
        __builtin_amdgcn_s_sleep(1);
        if ((++sp & 255u) == 0u) { if (xb_ld(&bar[XB_TMO])) break; if (sp > XB_SPIN_CAP) { atomicAdd(&bar[XB_TMO], 1u); break; } }
    }
    nloc = mine > 0u ? mine : 1u; nx = cnt > 0u ? cnt : 1u;
}
__device__ __forceinline__ void xcd_barrier(const XcdBarrier& b) {
    asm volatile("s_waitcnt vmcnt(0)" ::: "memory");
    __syncthreads();
    if (threadIdx.x == 0) {
        unsigned* bar = b.bar;
        __builtin_amdgcn_s_waitcnt(0);
        unsigned nloc = b.st[0], nx = b.st[1];
        if (nloc == 0u) { xcd_barrier_complete(bar, b.x, nloc, nx); b.st[0] = nloc; b.st[1] = nx; }
        const unsigned old = xb_add(&bar[XB_XSUB(b.x)], 1u);
        const unsigned gen = old / nloc;
        if (old + 1u == (gen + 1u) * nloc) {
            __builtin_amdgcn_fence(__ATOMIC_RELEASE, "agent");
            asm volatile("s_waitcnt vmcnt(0)" ::: "memory");
            const unsigned og = xb_add(&bar[XB_TOP], 1u);
            const unsigned tg = og / nx;
            if (og + 1u == (tg + 1u) * nx) xb_add(&bar[XB_TOPGEN], 1u);
            else XB_SPIN(xb_ld(&bar[XB_TOPGEN]) == tg, bar);
            __builtin_amdgcn_fence(__ATOMIC_ACQUIRE, "agent");
            xb_add(&bar[XB_XGEN(b.x)], 1u);
            asm volatile("s_waitcnt vmcnt(0)" ::: "memory");
        } else {
            XB_SPIN(xb_ld(&bar[XB_XGEN(b.x)]) == gen, bar);
            __builtin_amdgcn_fence(__ATOMIC_ACQUIRE, "agent");
            asm volatile("s_waitcnt vmcnt(0)" ::: "memory");
        }
    }
    __syncthreads();
}

#ifndef PROBE_DUP
#define PROBE_DUP 0
#endif
#ifndef PHM
#define PHM 0xFFFF
#endif
#define PH(b) if ((PHM >> (b)) & 1)
#define HB ((bf16_t*)(ws + WS_H))
#define P5 ((bf16_t*)(ws + WS_P5))
#define GT ((bf16_t*)(ws + WS_GT))
#define XC ((bf16_t*)(ws + WS_XC))
#define VT ((bf16_t*)(ws + WS_VT))
#define XH ((bf16_t*)(ws + WS_XH))
#define SB ((float*)(ws + WS_SB))
#define TPM ((bf16_t*)(ws + WS_TP))
#define W1M ((bf16_t*)(ws + WS_W1))
#define XSB ((bf16_t*)(ws + WS_XS))
#define AGG ((float*)(ws + WS_AGG))
#define LSG ((float*)(ws + WS_LSG))
#define MIX ((bf16_t*)(ws + WS_GT))
#define PART ((float*)(ws + WS_VT))
#define PART2 ((float*)(ws + WS_XC))
#define HID ((bf16_t*)(ws + WS_GT))
#define FFO ((bf16_t*)(ws + WS_P5))
#define WIN ((bf16_t*)(ws + WS_W + W_IN))
#define WBR ((bf16_t*)(ws + WS_W + W_BR))
#define WOUT ((bf16_t*)(ws + WS_W + W_OUT))
#define WGLU ((bf16_t*)(ws + WS_W + W_GLU))
#define WLRU ((bf16_t*)(ws + WS_W + W_LRU))
#define WF1 ((bf16_t*)(ws + WS_W + W_F1))
#define WF2 ((bf16_t*)(ws + WS_W + W_F2))
#define GASP __attribute__((address_space(1)))
#define PIN(i) ((const float*)(const GASP float*)(P.in[(i) + z]))
#define PHASE_BEGIN unsigned char* ws = opaque_ptr(P.ws); const int z = opaque_zero(); (void)ws; (void)z;
#define GSYNC() xcd_barrier(xbar)
constexpr int LDS_BYTES = 131072 + 1024;
__global__ void __launch_bounds__(512, 2) mega_fwd(Params P) {
    extern __shared__ __attribute__((aligned(16))) unsigned char lds_raw[];
    LAS unsigned char* lds = (LAS unsigned char*)lds_raw;
    cg::grid_group grid = cg::this_grid();
    const int G = gridDim.x, c = blockIdx.x;
    volatile LAS unsigned* bst = (volatile LAS unsigned*)(lds + 131072 + 512);
    if (threadIdx.x < 2) bst[threadIdx.x] = 0u;
    if (c == 0) for (int i = threadIdx.x; i < XCD_BAR_WORDS; i += 512) __hip_atomic_store((unsigned*)(P.ws + WS_BAR) + i, 0u, __ATOMIC_RELAXED, __HIP_MEMORY_SCOPE_AGENT);
    grid.sync();
    const XcdBarrier xbar = xcd_barrier_post((unsigned*)(P.ws + WS_BAR), bst);
    for (int l = 0; l < 2; ++l) {
        PH(0) { PHASE_BEGIN
            phase_norm(P, l == 0 ? 0 : 1, FFO, PIN(I_NORMW) + 3 * D, PIN(I_NORMW) + (size_t)l * 4 * D, HB, XSB, PART, 11); }
        for (int rep_ = 0; rep_ < ((PROBE_DUP & 16) ? 2 : 1); ++rep_) PH(1) { PHASE_BEGIN
            const int tid = opaque_tid(), lane = tid & 63, wave = __builtin_amdgcn_readfirstlane(tid >> 6); const int gw = c * 8 + wave, NGW = (G + z) * 8;
            const float* win = PIN(I_WIN) + (size_t)l * D * 12288; const float* wbr = PIN(I_WBR) + (size_t)l * 3 * 1024 * D; const float* wout = PIN(I_WOUT) + (size_t)l * D * D;
            const float* wglu = PIN(I_S5WG) + (size_t)l * 1024 * 1024;
            const int n_in = 32 * 48, n_br = 16 * 8, n_out = 32 * 8, n_glu = 16 * 4; const int tot = n_in + 3 * n_br + n_out + n_glu;
            { const int tot4 = tot * 4; const int s0 = (int)((unsigned)(gw * tot4) / (unsigned)NGW), s1 = (int)((unsigned)((gw + 1) * tot4) / (unsigned)NGW);
            for (int ss = s0; ss < s1; ++ss) {
                int r = ss >> 2; const int sub = ss & 3;
                if (r < n_in) { transpose_item<0>(win, D, 12288, WIN, r, sub, lane); continue; } r -= n_in;
                if (r < 3 * n_br) { const int i = r / n_br; transpose_item<0>(wbr + (size_t)i * 1024 * D, 1024, D, WBR + (size_t)i * D * 1024, r - i * n_br, sub, lane); continue; } r -= 3 * n_br;
                if (r < n_out) { transpose_item<0>(wout, D, D, WOUT, r, sub, lane); continue; } r -= n_out;
                transpose_item<0>(wglu, 1024, 1024, WGLU, r, sub, lane);
            } }
            const float* wa = PIN(I_LWA) + (size_t)l * 8 * 128 * 128; const float* wx = PIN(I_LWX) + (size_t)l * 8 * 128 * 128;
            for (int e = c * 512 + tid; e < 8 * 256 * 256; e += G * 512) { const int k = e & 255, n = (e >> 8) & 255, hh = e >> 16; float v = 0.f;
                if (k < 128) v = (n < 128) ? wa[((size_t)hh * 128 + k) * 128 + n] : wx[((size_t)hh * 128 + k) * 128 + (n - 128)];
                WLRU[e] = (bf16_t)(cvt_pk_bf16(v, 0.f) & 0xffffu); }
            if (c == 0) for (int e = tid; e < 1024; e += 512) LSG[e] = -8.0f * log1pf(expf(-(PIN(I_LLAM) + (size_t)l * 1024)[e]));
            __syncthreads();
            for (int t = c; t < 256; t += G)
                s5_gen_task(lds, t >> 2, t & 3, PIN(I_S5LR) + l * 4096, PIN(I_S5LI) + l * 4096, PIN(I_S5BR) + (size_t)l * 65536, PIN(I_S5BI) + (size_t)l * 65536,
                             PIN(I_S5CR) + (size_t)l * 65536, PIN(I_S5CI) + (size_t)l * 65536, PIN(I_S5LS) + l * 64, TPM, W1M);
        }
        GSYNC();
        PH(2) { PHASE_BEGIN
          pg8::DenseOrder S{HB, WIN, D, D, MP / 256, 12288 / 256, G, c, D / 64}; pg8::EpiG1 E{P5, XH, GT, PIN(I_BGATE) + (size_t)l * NGATE};
#if PROBE_DUP & 1
          pg8::gemm_phase(lds, D, D, S, E);
#endif
          pg8::gemm_phase(lds, D, D, S, E); }
        GSYNC();
        for (int rep_ = 0; rep_ < ((PROBE_DUP & 64) ? 2 : 1); ++rep_) PH(3) { PHASE_BEGIN
          phase_prep(lds, P5, XC, VT, PIN(I_CONVW) + (size_t)l * 4096, PIN(I_CONVB) + (size_t)l * 1024); }
        GSYNC();
        PH(4) { PHASE_BEGIN
          pg8::GroupOrder S{XC, WLRU, 1024, 256, MP / 256, 1, 8, 0, 256, 128, G, c, 4};
          pg8::EpiLru E{P5, XC, PIN(I_LBA) + (size_t)l * 1024, PIN(I_LBX) + (size_t)l * 1024, LSG};
          pg8::gemm_phase(lds, 1024, 256, S, E); }
        PH(5) { PHASE_BEGIN
          pg8::GroupOrder S{XH, W1M, XLD, 512, 3, 1, 64, XROWS, 128, 0, G, c, 8}; pg8::EpiS5S E{SB};
          pg8::gemm_phase(lds, XLD, 512, S, E); }
        PH(6) { PHASE_BEGIN
          const float lam_init = 0.8f - 0.6f * expf(-0.3f * (float)l);
#if PROBE_DUP & 2
          attn_phase(lds, P5, VT, PIN(I_RELB), PIN(I_DALAM) + (size_t)l * 256, PIN(I_DASUB) + (size_t)l * 128, lam_init, C_V);
#endif
          attn_phase(lds, P5, VT, PIN(I_RELB), PIN(I_DALAM) + (size_t)l * 256, PIN(I_DASUB) + (size_t)l * 128, lam_init, C_Q); }
        GSYNC();
        for (int rep_ = 0; rep_ < ((PROBE_DUP & 128) ? 2 : 1); ++rep_) PH(7) { PHASE_BEGIN
          lru_scan1(P5, XC, AGG);
          s5_carry(XH, SB, PIN(I_S5LR) + l * 4096, PIN(I_S5LI) + l * 4096, PIN(I_S5LS) + l * 64); }
        GSYNC();
        PH(8) { PHASE_BEGIN
          pg8::GroupOrder S{XH, TPM, XLD, XLD, 3, 2, 64, XROWS, 512, 0, G, c, 10}; pg8::EpiS5Y E{P5, XH, PIN(I_S5D) + (size_t)l * 1024};
          pg8::gemm_phase(lds, XLD, XLD, S, E); }
        PH(7) { PHASE_BEGIN
          lru_scan2(P5, XC, AGG); }
        GSYNC();
        PH(9) { PHASE_BEGIN
          pg8::DenseOrder S{P5 + C_V, WGLU, LDP, 1024, MP / 256, 4, G, c, 16}; pg8::EpiGlu E{P5, PIN(I_S5BG) + (size_t)l * 1024};
          pg8::gemm_phase(lds, LDP, 1024, S, E); }
        GSYNC();
        PH(10) { PHASE_BEGIN
          pg8::BranchOrder S{P5, WBR, LDP, 1024, MP / 256, 8, G, c, 16, 4}; pg8::EpiG2 E{GT, (u32x4*)(ws + WS_XH) + (size_t)c * 16 * 512, HB, PART2, 4};
          pg8::gemm_phase(lds, LDP, 1024, S, E); }
        GSYNC();
        PH(10) { PHASE_BEGIN
          pg8::g2_tail_reduce(PART2, 4, HB); }
        GSYNC();
        PH(11) { PHASE_BEGIN
          pg8::SplitOrder S{HB, WOUT, D, D, MP / 256, 8, G, c, D / 64, 4, 8}; pg8::EpiMix E{MIX, D, PART, 4};
          pg8::gemm_phase(lds, D, D, S, E); }
        GSYNC();
        PH(0) { PHASE_BEGIN
          const float* nw = PIN(I_NORMW) + (size_t)l * 4 * D;
          phase_norm(P, l == 0 ? 3 : 1, MIX, nw + D, nw + 2 * D, HB, XSB, PART, 4); }
        for (int rep_ = 0; rep_ < ((PROBE_DUP & 32) ? 2 : 1); ++rep_) PH(1) { PHASE_BEGIN
            const int tid = opaque_tid(), lane = tid & 63, wave = __builtin_amdgcn_readfirstlane(tid >> 6); const int gw = c * 8 + wave, NGW = (G + z) * 8;
            const float* wf1 = PIN(I_WF1) + (size_t)l * D * 2 * DFF; const float* wf2 = PIN(I_WF2) + (size_t)l * DFF * D;
            const int n1 = 32 * 44, n2 = 88 * 8;
            { const int tot4 = (n1 + n2) * 4; const int s0 = (int)((unsigned)(gw * tot4) / (unsigned)NGW), s1 = (int)((unsigned)((gw + 1) * tot4) / (unsigned)NGW);
            for (int ss = s0; ss < s1; ++ss) {
                const int it = ss >> 2, sub = ss & 3;
                if (it < n1) transpose_item<1>(wf1, D, 2 * DFF, WF1, it, sub, lane);
                else transpose_item<0>(wf2, DFF, D, WF2, it - n1, sub, lane);
            } }
        }
        GSYNC();
        PH(12) { PHASE_BEGIN
          pg8::DenseOrder S{HB, WF1, D, D, MP / 256, 44, G, c, D / 64}; pg8::EpiSwiglu E{HID};
#if PROBE_DUP & 256
          pg8::gemm_phase(lds, D, D, S, E);
#endif
          pg8::gemm_phase(lds, D, D, S, E); }
        GSYNC();
        PH(11) { PHASE_BEGIN
          pg8::SplitOrder S{HID, WF2, DFF, DFF, MP / 256, 8, G, c, DFF / 64, 11, 8}; pg8::EpiMix E{FFO, D, PART, 11};
#if PROBE_DUP & 8
          pg8::gemm_phase(lds, DFF, DFF, S, E);
#endif
          pg8::gemm_phase(lds, DFF, DFF, S, E); }
        GSYNC();
    }
    PH(0) { PHASE_BEGIN
      phase_norm(P, 2, FFO, PIN(I_NORMW) + (size_t)(4 + 3) * D, nullptr, HB, XSB, PART, 11); }
}

extern "C" void kernel_launch(void* const* d_in, const int* in_sizes, int n_in, void* d_out, int out_size, void* d_ws, size_t ws_size, hipStream_t stream) {
    static int grid_blocks = 0;
    if (!grid_blocks) {
        int dev = 0, cus = 0, per_cu = 0;
        hipGetDevice(&dev);
        hipDeviceGetAttribute(&cus, hipDeviceAttributeMultiprocessorCount, dev);
        hipFuncSetAttribute((const void*)mega_fwd, hipFuncAttributeMaxDynamicSharedMemorySize, LDS_BYTES);
        hipOccupancyMaxActiveBlocksPerMultiprocessor(&per_cu, (const void*)mega_fwd, 512, LDS_BYTES);
        if (per_cu < 1) per_cu = 1;
        grid_blocks = cus * per_cu;
        if (ws_size < WS_END) fprintf(stderr, "kernel_launch: workspace too small: %zu < %zu\n", ws_size, (size_t)WS_END);
    }
    Params p{};
    for (int i = 0; i < 29; ++i) p.in[i] = (const float*)d_in[i];
    p.out = (float*)d_out; p.ws = (unsigned char*)d_ws;
    void* args[] = {&p};
    hipError_t e = hipLaunchCooperativeKernel((const void*)mega_fwd, dim3(grid_blocks), dim3(512), args, LDS_BYTES, stream);
    if (e != hipSuccess) fprintf(stderr, "cooperative launch failed: %s (grid %d)\n", hipGetErrorString(e), grid_blocks);
}
```

```cpp
#include <hip/hip_runtime.h>
#include <hip/hip_cooperative_groups.h>
#include <cstdio>
#include <cstdint>
namespace cg = cooperative_groups;

#define LAS __attribute__((address_space(3)))
typedef unsigned short bf16_t;
typedef short bf16x8 __attribute__((ext_vector_type(8)));
typedef short bf16x4 __attribute__((ext_vector_type(4)));
typedef float f32x4 __attribute__((ext_vector_type(4)));
typedef float f32x2 __attribute__((ext_vector_type(2)));
typedef unsigned u32x4 __attribute__((ext_vector_type(4)));
typedef unsigned u32x2 __attribute__((ext_vector_type(2)));

constexpr int NB = 4, SEQ = 4096, PADT = 48, TP = 4160, MP = NB * TP;
constexpr int D = 2048, DFF = 5632, LDP = 5120, NGATE = 6144;
constexpr int C_AG = 0, C_AX = 1024, C_Q = 2048, C_K = 3072, C_V = 4096;
constexpr int NCH32 = 130, XROWS = 768, XLD = 640;
constexpr int NCH64 = 65;
constexpr float LOG2E = 1.4426950408889634f;

constexpr size_t MiB = 1u << 20;
constexpr size_t WS_W = 0;
constexpr size_t W_IN = 0, W_BR = 48 * MiB, W_OUT = 60 * MiB, W_GLU = 68 * MiB, W_LRU = 70 * MiB;
constexpr size_t W_F1 = 0, W_F2 = 44 * MiB;
constexpr size_t WS_H = 72 * MiB;
constexpr size_t WS_P5 = 137 * MiB;
constexpr size_t WS_GT = 300 * MiB;
constexpr size_t WS_XC = 495 * MiB;
constexpr size_t WS_VT = 528 * MiB;
constexpr size_t WS_XH = 561 * MiB;
constexpr size_t WS_SB = 621 * MiB;
constexpr size_t WS_TP = 645 * MiB;
constexpr size_t WS_W1 = 685 * MiB;
constexpr size_t WS_AGG = 694 * MiB;
constexpr size_t WS_LSG = 697 * MiB;
constexpr size_t WS_BAR = 697 * MiB + 65536;
constexpr size_t WS_XS = 698 * MiB;
constexpr size_t WS_END = 763 * MiB;

struct Params { const float* in[29]; float* out; unsigned char* ws; };
enum { I_X = 0, I_META, I_RELB, I_NORMW, I_WIN, I_CONVW, I_CONVB, I_LWA, I_LBA, I_LWX, I_LBX, I_LLAM, I_DALAM, I_DASUB, I_S5LR, I_S5LI,
       I_S5BR, I_S5BI, I_S5CR, I_S5CI, I_S5D, I_S5LS, I_S5WG, I_S5BG, I_BGATE, I_WBR, I_WOUT, I_WF1, I_WF2 };

__device__ __forceinline__ int opaque_zero() { int z = 0; asm volatile("" : "+v"(z)); return __builtin_amdgcn_readfirstlane(z); }
__device__ __forceinline__ unsigned char* opaque_ptr(unsigned char* p) { const unsigned long long u = (unsigned long long)p; int lo = (int)(unsigned)u, hi = (int)(unsigned)(u >> 32);
    asm volatile("" : "+v"(lo), "+v"(hi)); lo = __builtin_amdgcn_readfirstlane(lo); hi = __builtin_amdgcn_readfirstlane(hi);
    return (unsigned char*)(__attribute__((address_space(1))) unsigned char*)(((unsigned long long)(unsigned)hi << 32) | (unsigned)lo); }
__device__ __forceinline__ int opaque_tid() { int t = threadIdx.x; asm volatile("" : "+v"(t)); return t; }
__device__ __forceinline__ unsigned cvt_pk_bf16(float lo, float hi) { unsigned r; asm volatile("v_cvt_pk_bf16_f32 %0, %1, %2" : "=v"(r) : "v"(lo), "v"(hi)); return r; }
__device__ __forceinline__ float bf_lo(unsigned w) { return __uint_as_float(w << 16); }
__device__ __forceinline__ float bf_hi(unsigned w) { return __uint_as_float(w & 0xffff0000u); }
__device__ __forceinline__ float bf2f(bf16_t v) { return __uint_as_float(((unsigned)v) << 16); }
__device__ __forceinline__ float sigmoidf_(float x) { return __builtin_amdgcn_rcpf(1.0f + __builtin_amdgcn_exp2f(-1.4426950408889634f * x)); }
__device__ __forceinline__ float gelu_tanh(float x) { const float u = 1.5957691216057308f * (x + 0.044715f * x * x * x); return x * sigmoidf_(u); }
__device__ __forceinline__ float wave_sum(float v) {
    v += __builtin_bit_cast(float, __builtin_amdgcn_update_dpp(0, __builtin_bit_cast(int, v), 0xB1, 0xF, 0xF, true));
    v += __builtin_bit_cast(float, __builtin_amdgcn_update_dpp(0, __builtin_bit_cast(int, v), 0x4E, 0xF, 0xF, true));
    v += __builtin_bit_cast(float, __builtin_amdgcn_update_dpp(0, __builtin_bit_cast(int, v), 0x124, 0xF, 0xF, true));
    v += __builtin_bit_cast(float, __builtin_amdgcn_update_dpp(0, __builtin_bit_cast(int, v), 0x128, 0xF, 0xF, true));
    unsigned a = __float_as_uint(v); auto r = __builtin_amdgcn_permlane16_swap(a, a, false, false); v = __uint_as_float(r[0]) + __uint_as_float(r[1]);
    a = __float_as_uint(v); auto r2 = __builtin_amdgcn_permlane32_swap(a, a, false, false); return __uint_as_float(r2[0]) + __uint_as_float(r2[1]);
}
__device__ __forceinline__ float* xs_row(float* out, float* metab, int m) {
    const int b = m / TP, tp = m - b * TP;
    if (tp < PADT) return nullptr;
    if (tp < 64) return metab + (size_t)(b * 16 + tp - PADT) * D;
    return out + ((size_t)b * SEQ + (tp - 64)) * D;
}

namespace pg8 {
constexpr int BM = 256, BK = 64, HALF = 128, HTB = HALF * BK * 2, STAGE_BYTES = 8 * HTB, NXCD = 8, WGM = 8;
__device__ __forceinline__ int lds_byte(int r, int c) { const int st = (r >> 4) * 2 + (c >> 5), rr = r & 15, cc = c & 31, ob = rr * 64 + cc * 2; return st * 1024 + (ob ^ (((ob >> 9) & 1) << 5)); }
__device__ __forceinline__ void stage_rc(int b, int& R, int& C) { const int st = b / 1024, sb = b % 1024, swz = sb ^ (((sb >> 9) & 1) << 5); R = (st >> 1) * 16 + swz / 64; C = (st & 1) * 32 + (swz % 64) / 2; }
__device__ __forceinline__ int perm32(int rho) { const int n = rho >> 4, i = rho & 15; return 8 * (i >> 2) + 4 * n + (i & 3); }

struct Unit { const char* A; const char* B; int pm, pn, aux, nt; };

__device__ __forceinline__ void dense_tile(int L, int nM, int nN, int& pm, int& pn) {
    const int nwg = nM * nN; int wgid = L;
    { const int q = nwg / NXCD, r = nwg % NXCD, xcd = wgid % NXCD, off = wgid / NXCD; wgid = (xcd < r ? xcd * (q + 1) : r * (q + 1) + (xcd - r) * q) + off; }
    const int nig = WGM * nN, gid = wgid / nig, fm = gid * WGM, gsz = (nM - fm) < WGM ? (nM - fm) : WGM;
    pm = fm + ((wgid % nig) % gsz); pn = (wgid % nig) / gsz;
}
struct DenseOrder {
    const bf16_t* A; const bf16_t* Bt; int lda, ldb, nM, nN, G, c, ntk;
    __device__ __forceinline__ bool next(int i, Unit& u) const {
        const int L = i * G + c; if (L >= nM * nN) return false;
        int pm, pn; dense_tile(L, nM, nN, pm, pn);
        u.pm = pm; u.pn = pn; u.aux = 0; u.nt = ntk;
        u.A = (const char*)(A + (size_t)pm * 256 * lda); u.B = (const char*)(Bt + (size_t)pn * 256 * ldb); return true;
    }
};
struct SplitOrder {
    const bf16_t* A; const bf16_t* Bt; int lda, ldb, nM, nN, G, c, ntk, pieces, nt_piece;
    __device__ __forceinline__ bool next(int i, Unit& u) const {
        const int nfull = (nM - 1) * nN; const int L = i * G + c; int pm, pn, pc = 0, full = 1;
        if (L < nfull) dense_tile(L, nM - 1, nN, pm, pn);
        else { const int s_ = L - nfull; if (s_ >= nN * pieces) return false; pn = s_ / pieces; pc = s_ - pn * pieces; pm = nM - 1; full = 0; }
        u.pm = pm; u.pn = pn; u.aux = full ? 0 : 1 + pc; u.nt = full ? ntk : nt_piece;
        u.A = (const char*)(A + (size_t)pm * 256 * lda + (size_t)pc * nt_piece * 64); u.B = (const char*)(Bt + (size_t)pn * 256 * ldb + (size_t)pc * nt_piece * 64); return true;
    }
};
struct BranchOrder {
    const bf16_t* A0; const bf16_t* Bt; int lda, ldb, nM, nN, G, c, ntk, pieces;
    __device__ __forceinline__ bool next(int i, Unit& u) const {
        const int nfull = (nM - 1) * nN, rounds = nfull / G;
        int pm, pn, br, pc = 0;
        if (i < 3 * rounds) { const int r = i / 3; br = i - 3 * r; dense_tile(r * G + c, nM - 1, nN, pm, pn); u.nt = ntk; u.aux = br; }
        else { const int s_ = (i - 3 * rounds) * G + c; if (s_ >= nN * 3 * pieces) return false;
            pn = s_ / (3 * pieces); const int rem = s_ - pn * 3 * pieces; br = rem / pieces; pc = rem - br * pieces; pm = nM - 1; u.nt = ntk / pieces; u.aux = br | ((1 + pc) << 2); }
        u.pm = pm; u.pn = pn;
        const int acol = br == 0 ? C_AG : (br == 1 ? C_Q : C_K);
        u.A = (const char*)(A0 + (size_t)pm * 256 * lda + acol + (size_t)pc * (ntk / pieces) * 64);
        u.B = (const char*)(Bt + (size_t)br * 2048 * 1024 + (size_t)pn * 256 * ldb + (size_t)pc * (ntk / pieces) * 64); return true;
    }
};
struct GroupOrder {
    const bf16_t* A; const bf16_t* Bt; int lda, ldb, nM, nN, ngroups, a_gstride_rows, b_gstride_rows, a_gcol, G, c, ntk;
    __device__ __forceinline__ bool next(int i, Unit& u) const {
        const int L = i * G + c; const int per = nM * nN; if (L >= per * ngroups) return false;
        const int g = L / per, r = L - g * per; const int pm = r / nN, pn = r - pm * nN;
        u.pm = pm; u.pn = pn; u.aux = g; u.nt = ntk;
        u.A = (const char*)(A + ((size_t)g * a_gstride_rows + (size_t)pm * 256) * lda + (size_t)g * a_gcol);
        u.B = (const char*)(Bt + ((size_t)g * b_gstride_rows + (size_t)pn * 256) * ldb); return true;
    }
};

template <class Epi, class Sched>
__device__ __forceinline__ void gemm_phase(LAS unsigned char* lds, const int lda, const int ldb, const Sched& S, const Epi& E) {
    int tid_ = threadIdx.x; asm volatile("" : "+v"(tid_));
    const int tid = tid_, wid = __builtin_amdgcn_readfirstlane(tid >> 6), lane = tid & 63, wr = wid >> 2, wc = wid & 3, fr = lane & 15, fq = lane >> 4;
    unsigned voffA[2], voffB[2];
#pragma unroll
    for (int i = 0; i < 2; ++i) { int R, C; stage_rc(tid * 16 + i * 8192, R, C); const int Rb = Epi::PERM ? ((R & ~31) + perm32(R & 31)) : R;
        voffA[i] = (unsigned)(R * lda + C) * 2u; voffB[i] = (unsigned)(Rb * ldb + C) * 2u; }
    const size_t kstep = (size_t)(BK * 2);
    const size_t hstepA = (size_t)HALF * lda * 2, hstepB = (size_t)HALF * ldb * 2;
    const unsigned ldsw = (unsigned)wid * 1024u;
    const int aoff = lds_byte(wr * 64 + fr, fq * 8), boff = lds_byte(wc * 32 + fr, fq * 8);
#define PG8_SA(b, h) (((b) * 2 + (h)) * HTB)
#define PG8_SB(b, h) ((4 + (b) * 2 + (h)) * HTB)
#define PG8_STAGE(bufoff, gbase, voff) do { _Pragma("unroll") for (int _i = 0; _i < 2; ++_i) \
        __builtin_amdgcn_global_load_lds((const unsigned*)((const char*)(gbase) + (voff)[_i]), (LAS unsigned*)(lds + (bufoff) + ldsw + _i * 8192), 16, 0, 0); } while (0)
#define PG8_LDA(dst, b, h) do { _Pragma("unroll") for (int m = 0; m < 4; ++m) _Pragma("unroll") for (int k = 0; k < 2; ++k) dst[m][k] = *(const LAS bf16x8*)(lds + PG8_SA(b, h) + aoff + m * 2048 + k * 1024); } while (0)
#define PG8_LDB(dst, b, h) do { _Pragma("unroll") for (int n = 0; n < 2; ++n) _Pragma("unroll") for (int k = 0; k < 2; ++k) dst[n][k] = *(const LAS bf16x8*)(lds + PG8_SB(b, h) + boff + n * 2048 + k * 1024); } while (0)
#define PG8_MMA(ai, bj, At, Bt) do { __builtin_amdgcn_s_setprio(1); _Pragma("unroll") for (int m = 0; m < 4; ++m) _Pragma("unroll") for (int n = 0; n < 2; ++n) _Pragma("unroll") for (int k = 0; k < 2; ++k) \
        acc[ai][bj][m][n] = __builtin_amdgcn_mfma_f32_16x16x32_bf16(Bt[n][k], At[m][k], acc[ai][bj][m][n], 0, 0, 0); __builtin_amdgcn_s_setprio(0); } while (0)
#define PG8_WAIT_V(n) asm volatile("s_waitcnt vmcnt(" #n ")" ::: "memory")
#define PG8_WAIT_L(n) asm volatile("s_waitcnt lgkmcnt(" #n ")" ::: "memory")
#define PG8_BAR __builtin_amdgcn_s_barrier()
#define PG8_SCHED __builtin_amdgcn_sched_barrier(0)
    Unit cur, nxt; int ui = 0;
    if (!S.next(0, cur)) return;
    f32x4 acc[2][2][4][2];
#pragma unroll
    for (int a = 0; a < 2; ++a)
#pragma unroll
        for (int b = 0; b < 2; ++b)
#pragma unroll
            for (int m = 0; m < 4; ++m)
#pragma unroll
                for (int n = 0; n < 2; ++n) acc[a][b][m][n] = (f32x4){0.f, 0.f, 0.f, 0.f};
    bf16x8 At[4][2], B0[2][2], B1[2][2];
    const char* cA = cur.A; const char* cB = cur.B; asm volatile("" : "+s"(cA), "+s"(cB));
    PG8_STAGE(PG8_SB(0, 0), cB, voffB); PG8_STAGE(PG8_SB(0, 1), cB + hstepB, voffB); PG8_STAGE(PG8_SA(0, 0), cA, voffA); PG8_STAGE(PG8_SA(0, 1), cA + hstepA, voffA);
    if (wr == 1) PG8_BAR;
    PG8_WAIT_V(2); PG8_BAR;
    PG8_STAGE(PG8_SB(1, 0), cB + kstep, voffB); PG8_STAGE(PG8_SA(1, 0), cA + kstep, voffA); PG8_STAGE(PG8_SB(1, 1), cB + hstepB + kstep, voffB);
    PG8_WAIT_V(6); PG8_BAR;
    for (;;) {
        const bool has_next = S.next(ui + 1, nxt);
        const char* nA = has_next ? nxt.A : cA; const char* nB = has_next ? nxt.B : cB;
        const int nt = cur.nt;
#pragma unroll 1
        for (int t = 0; t < nt; t += 2) {
            const bool last = (t == nt - 2);
            const char* a1 = cA + (size_t)(t + 1) * kstep;
            const char* a2 = last ? nA : cA + (size_t)(t + 2) * kstep; const char* b2 = last ? nB : cB + (size_t)(t + 2) * kstep;
            const char* a3 = a2 + kstep; const char* b3 = b2 + kstep;
            PG8_LDB(B0, 0, 0); PG8_LDB(B1, 0, 1); PG8_SCHED; PG8_LDA(At, 0, 0); PG8_STAGE(PG8_SA(1, 1), a1 + hstepA, voffA);
            PG8_WAIT_V(8); PG8_WAIT_L(0); PG8_BAR; PG8_MMA(0, 0, At, B0); PG8_MMA(0, 1, At, B1); PG8_BAR; PG8_SCHED;
            PG8_LDA(At, 0, 1); PG8_STAGE(PG8_SB(0, 0), b2, voffB); PG8_STAGE(PG8_SB(0, 1), b2 + hstepB, voffB); PG8_STAGE(PG8_SA(0, 0), a2, voffA);
            PG8_WAIT_V(8); PG8_WAIT_L(0); PG8_BAR; PG8_MMA(1, 0, At, B0); PG8_MMA(1, 1, At, B1); PG8_BAR; PG8_SCHED;
            PG8_LDB(B0, 1, 0); PG8_LDB(B1, 1, 1); PG8_SCHED; PG8_LDA(At, 1, 0); PG8_STAGE(PG8_SA(0, 1), a2 + hstepA, voffA);
            PG8_WAIT_V(8); PG8_WAIT_L(0); PG8_BAR; PG8_MMA(0, 0, At, B0); PG8_MMA(0, 1, At, B1); PG8_BAR; PG8_SCHED;
            PG8_LDA(At, 1, 1); PG8_STAGE(PG8_SB(1, 0), b3, voffB); PG8_STAGE(PG8_SB(1, 1), b3 + hstepB, voffB); PG8_STAGE(PG8_SA(1, 0), a3, voffA);
            PG8_WAIT_V(8); PG8_WAIT_L(0); PG8_BAR; PG8_MMA(1, 0, At, B0); PG8_MMA(1, 1, At, B1); PG8_BAR; PG8_SCHED;
        }
        if (wr == 0) PG8_BAR;
        { const int t2 = opaque_tid(); const int w2 = __builtin_amdgcn_readfirstlane(t2 >> 6); E(acc, cur, w2 >> 2, w2 & 3, t2 & 15, (t2 & 63) >> 4); }
        if (!has_next) break;
#pragma unroll
        for (int a = 0; a < 2; ++a)
#pragma unroll
            for (int b = 0; b < 2; ++b)
#pragma unroll
                for (int m = 0; m < 4; ++m)
#pragma unroll
                    for (int n = 0; n < 2; ++n) acc[a][b][m][n] = (f32x4){0.f, 0.f, 0.f, 0.f};
        cur = nxt; cA = nA; cB = nB; ++ui;
        if (wr == 1) PG8_BAR;
    }
    PG8_WAIT_V(0);
    PG8_BAR;
#undef PG8_SA
#undef PG8_SB
#undef PG8_STAGE
#undef PG8_LDA
#undef PG8_LDB
#undef PG8_MMA
#undef PG8_WAIT_V
#undef PG8_WAIT_L
#undef PG8_BAR
#undef PG8_SCHED
}

typedef f32x4 Acc[2][2][4][2];

struct EpiG1 {
    static constexpr bool PERM = true;
    bf16_t* p5; bf16_t* xh; bf16_t* gates; const float* bgate;
    __device__ __forceinline__ void operator()(const Acc& acc, const Unit& u, int wr, int wc, int fr, int fq) const {
        const int row0 = u.pm * 256 + wr * 64 + fr; const int pn = u.pn;
        f32x4 gb[2][2];
#pragma unroll
        for (int bj = 0; bj < 2; ++bj) { const int cg_ = (pn >= 24 ? (pn - 24) * 256 : 0) + bj * 128 + wc * 32 + 8 * fq;
            gb[bj][0] = *(const f32x4*)(bgate + cg_); gb[bj][1] = *(const f32x4*)(bgate + cg_ + 4); }
#pragma unroll
        for (int ai = 0; ai < 2; ++ai)
#pragma unroll
            for (int m = 0; m < 4; ++m) {
                const int row = row0 + ai * 128 + m * 16;
#pragma unroll
                for (int bj = 0; bj < 2; ++bj) {
                    const int colt = bj * 128 + wc * 32 + 8 * fq;
                    f32x4 v0 = acc[ai][bj][m][0], v1 = acc[ai][bj][m][1];
                    bf16_t* dst;
                    if (pn < 20) dst = p5 + (size_t)row * LDP + pn * 256 + colt;
                    else if (pn < 24) {
                        const int cu = (pn - 20) * 256 + colt, g = cu >> 4, c0 = cu & 15;
                        const int b = row / TP, tp = row - b * TP, chunk = tp >> 5, jj = tp & 31;
                        dst = xh + ((size_t)g * XROWS + b * NCH32 + chunk) * XLD + jj * 16 + c0;
                    } else {
                        const int cg_ = (pn - 24) * 256 + colt;
                        unsigned q0 = 0u, q1 = 0u;
#pragma unroll
                        for (int j = 0; j < 4; ++j) { q0 |= (unsigned)(sigmoidf_(v0[j] + gb[bj][0][j]) * 255.0f + 0.5f) << (8 * j); q1 |= (unsigned)(sigmoidf_(v1[j] + gb[bj][1][j]) * 255.0f + 0.5f) << (8 * j); }
                        *(u32x2*)((unsigned char*)gates + (size_t)row * NGATE + cg_) = (u32x2){q0, q1};
                        continue;
                    }
                    u32x4 w; w.x = cvt_pk_bf16(v0[0], v0[1]); w.y = cvt_pk_bf16(v0[2], v0[3]); w.z = cvt_pk_bf16(v1[0], v1[1]); w.w = cvt_pk_bf16(v1[2], v1[3]);
                    *(u32x4*)dst = w;
                }
            }
    }
};
struct EpiLru {
    static constexpr bool PERM = true;
    bf16_t* p5; bf16_t* xc; const float* ba; const float* bx; const float* lsgp;
    __device__ __forceinline__ void operator()(const Acc& acc, const Unit& u, int wr, int wc, int fr, int fq) const {
        const int row0 = u.pm * 256 + wr * 64 + fr; int chb = u.aux * 128 + wc * 32 + 8 * fq; asm volatile("" : "+v"(chb));
#pragma unroll
        for (int n = 0; n < 2; ++n) {
            const int ch0 = chb + 4 * n;
            const f32x4 lsg = *(const f32x4*)(lsgp + ch0), bav = *(const f32x4*)(ba + ch0), bxv = *(const f32x4*)(bx + ch0);
            u32x2 xw[2][4];
#pragma unroll
            for (int ai = 0; ai < 2; ++ai)
#pragma unroll
                for (int m = 0; m < 4; ++m) xw[ai][m] = *(const u32x2*)(xc + (size_t)(row0 + ai * 128 + m * 16) * 1024 + ch0);
#pragma unroll
            for (int ai = 0; ai < 2; ++ai)
#pragma unroll
                for (int m = 0; m < 4; ++m) {
                    const int row = row0 + ai * 128 + m * 16; const int tp = row % TP;
                    const float xv[4] = {bf_lo(xw[ai][m].x), bf_hi(xw[ai][m].x), bf_lo(xw[ai][m].y), bf_hi(xw[ai][m].y)};
                    float la[4], bb[4];
#pragma unroll
                    for (int j = 0; j < 4; ++j) {
                        const float rp = acc[ai][0][m][n][j], ip = acc[ai][1][m][n][j];
                        const float l_ = lsg[j] * sigmoidf_(rp + bav[j]);
                        la[j] = l_;
                        const float t2 = 1.0f - __expf(2.0f * l_);
                        bb[j] = (tp < PADT) ? 0.0f : sqrtf(fmaxf(t2, 0.0f)) * sigmoidf_(ip + bxv[j]) * xv[j];
                    }
                    *(u32x2*)(p5 + (size_t)row * LDP + C_AX + ch0) = (u32x2){cvt_pk_bf16(la[0], la[1]), cvt_pk_bf16(la[2], la[3])};
                    *(u32x2*)(xc + (size_t)row * 1024 + ch0) = (u32x2){cvt_pk_bf16(bb[0], bb[1]), cvt_pk_bf16(bb[2], bb[3])};
                }
            asm volatile("" ::: "memory");
        }
    }
};
struct EpiS5S {
    static constexpr bool PERM = false;
    float* sb;
    __device__ __forceinline__ void operator()(const Acc& acc, const Unit& u, int wr, int wc, int fr, int fq) const {
        const int row0 = u.aux * XROWS + u.pm * 256 + wr * 64 + fr; const int col0 = wc * 32 + 4 * fq;
#pragma unroll
        for (int ai = 0; ai < 2; ++ai)
#pragma unroll
            for (int m = 0; m < 4; ++m) { float* rowp = sb + (size_t)(row0 + ai * 128 + m * 16) * 128 + col0;
#pragma unroll
                for (int n = 0; n < 2; ++n) *(f32x4*)(rowp + n * 16) = acc[ai][0][m][n]; }
    }
};
struct EpiS5Y {
    static constexpr bool PERM = true;
    bf16_t* p5; const bf16_t* xh; const float* dsk;
    __device__ __forceinline__ void operator()(const Acc& acc, const Unit& u, int wr, int wc, int fr, int fq) const {
        const int g = u.aux; const int rr0 = u.pm * 256 + wr * 64 + fr;
        f32x4 dv[2][2];
#pragma unroll
        for (int bj = 0; bj < 2; ++bj) { const int n0 = u.pn * 256 + bj * 128 + wc * 32 + 8 * fq; const int ch = g * 16 + (n0 & 15);
            dv[bj][0] = *(const f32x4*)(dsk + ch); dv[bj][1] = *(const f32x4*)(dsk + ch + 4); }
#pragma unroll
        for (int ai = 0; ai < 2; ++ai) {
            u32x4 uw[4][2];
#pragma unroll
            for (int m = 0; m < 4; ++m)
#pragma unroll
                for (int bj = 0; bj < 2; ++bj) uw[m][bj] = *(const u32x4*)(xh + ((size_t)g * XROWS + rr0 + ai * 128 + m * 16) * XLD + u.pn * 256 + bj * 128 + wc * 32 + 8 * fq);
#pragma unroll
            for (int m = 0; m < 4; ++m) {
                const int rr = rr0 + ai * 128 + m * 16;
                if (rr < NB * NCH32) {
                    const int b = rr / NCH32, chunk = rr - b * NCH32;
#pragma unroll
                    for (int bj = 0; bj < 2; ++bj) {
                        const int n0 = u.pn * 256 + bj * 128 + wc * 32 + 8 * fq; const int i = n0 >> 4, co0 = n0 & 15;
                        const u32x4 w_ = uw[m][bj];
                        const float uv[8] = {bf_lo(w_.x), bf_hi(w_.x), bf_lo(w_.y), bf_hi(w_.y), bf_lo(w_.z), bf_hi(w_.z), bf_lo(w_.w), bf_hi(w_.w)};
                        const int ch = g * 16 + co0; float y[8];
#pragma unroll
                        for (int j = 0; j < 8; ++j) y[j] = gelu_tanh(acc[ai][bj][m][j >> 2][j & 3] + dv[bj][j >> 2][j & 3] * uv[j]);
                        u32x4 w; w.x = cvt_pk_bf16(y[0], y[1]); w.y = cvt_pk_bf16(y[2], y[3]); w.z = cvt_pk_bf16(y[4], y[5]); w.w = cvt_pk_bf16(y[6], y[7]);
                        *(u32x4*)(p5 + ((size_t)b * TP + chunk * 32 + i) * LDP + C_V + ch) = w;
                    }
                }
            }
            asm volatile("" ::: "memory");
        }
    }
};
struct EpiGlu {
    static constexpr bool PERM = true;
    bf16_t* p5; const float* bglu;
    __device__ __forceinline__ void operator()(const Acc& acc, const Unit& u, int wr, int wc, int fr, int fq) const {
        const int row0 = u.pm * 256 + wr * 64 + fr;
#pragma unroll
        for (int bj = 0; bj < 2; ++bj) {
            const int col = u.pn * 256 + bj * 128 + wc * 32 + 8 * fq;
            const f32x4 b0 = *(const f32x4*)(bglu + col), b1 = *(const f32x4*)(bglu + col + 4);
            u32x4 yw[2][4];
#pragma unroll
            for (int ai = 0; ai < 2; ++ai)
#pragma unroll
                for (int m = 0; m < 4; ++m) yw[ai][m] = *(const u32x4*)(p5 + (size_t)(row0 + ai * 128 + m * 16) * LDP + C_V + col);
#pragma unroll
            for (int ai = 0; ai < 2; ++ai)
#pragma unroll
                for (int m = 0; m < 4; ++m) {
                    const int row = row0 + ai * 128 + m * 16; const u32x4 w_ = yw[ai][m];
                    const float yv[8] = {bf_lo(w_.x), bf_hi(w_.x), bf_lo(w_.y), bf_hi(w_.y), bf_lo(w_.z), bf_hi(w_.z), bf_lo(w_.w), bf_hi(w_.w)};
                    float o[8];
#pragma unroll
                    for (int j = 0; j < 8; ++j) o[j] = yv[j] * sigmoidf_(acc[ai][bj][m][j >> 2][j & 3] + (j < 4 ? b0[j & 3] : b1[j & 3]));
                    u32x4 w; w.x = cvt_pk_bf16(o[0], o[1]); w.y = cvt_pk_bf16(o[2], o[3]); w.z = cvt_pk_bf16(o[4], o[5]); w.w = cvt_pk_bf16(o[6], o[7]);
                    *(u32x4*)(p5 + (size_t)row * LDP + C_K + col) = w;
                }
            asm volatile("" ::: "memory");
        }
    }
};
struct EpiG2 {
    static constexpr bool PERM = true;
    const bf16_t* gates; u32x4* scr; bf16_t* merged; float* part; int pieces;
    __device__ __forceinline__ void operator()(const Acc& acc, const Unit& u, int wr, int wc, int fr, int fq) const {
        const int row0 = u.pm * 256 + wr * 64 + fr; const int br = u.aux & 3, pcs = u.aux >> 2;
        unsigned soff = (unsigned)opaque_tid();
        float* pbase = part + (size_t)((u.pn * 3 + br) * pieces + (pcs - 1)) * 65536;
#pragma unroll
        for (int ai = 0; ai < 2; ++ai)
#pragma unroll
            for (int mh = 0; mh < 2; ++mh) {
                u32x2 gw[2][2]; u32x4 ps[2][2];
#pragma unroll
                for (int mm = 0; mm < 2; ++mm)
#pragma unroll
                    for (int bj = 0; bj < 2; ++bj) {
                        const int row = row0 + ai * 128 + (2 * mh + mm) * 16, col = u.pn * 256 + bj * 128 + wc * 32 + 8 * fq;
                        gw[mm][bj] = *(const u32x2*)((const unsigned char*)gates + (size_t)row * NGATE + br * 2048 + col);
                        if (br > 0 && pcs == 0) ps[mm][bj] = scr[soff + (mm * 2 + bj) * 512];
                    }
#pragma unroll
                for (int mm = 0; mm < 2; ++mm)
#pragma unroll
                    for (int bj = 0; bj < 2; ++bj) {
                        const int m = 2 * mh + mm; const int row = row0 + ai * 128 + m * 16; const int colt = bj * 128 + wc * 32 + 8 * fq, col = u.pn * 256 + colt;
                        const u32x2 g_ = gw[mm][bj]; const float k255 = 1.0f / 255.0f;
                        f32x4 v0 = acc[ai][bj][m][0], v1 = acc[ai][bj][m][1];
#pragma unroll
                        for (int j = 0; j < 4; ++j) { v0[j] *= (float)((g_.x >> (8 * j)) & 0xffu) * k255; v1[j] *= (float)((g_.y >> (8 * j)) & 0xffu) * k255; }
                        if (pcs) { float* d = pbase + (size_t)(wr * 64 + fr + ai * 128 + m * 16) * 256 + colt; *(f32x4*)d = v0; *(f32x4*)(d + 4) = v1; }
                        else {
                            if (br > 0) { const u32x4 p_ = ps[mm][bj];
                                v0[0] += bf_lo(p_.x); v0[1] += bf_hi(p_.x); v0[2] += bf_lo(p_.y); v0[3] += bf_hi(p_.y);
                                v1[0] += bf_lo(p_.z); v1[1] += bf_hi(p_.z); v1[2] += bf_lo(p_.w); v1[3] += bf_hi(p_.w); }
                            u32x4 w; w.x = cvt_pk_bf16(v0[0], v0[1]); w.y = cvt_pk_bf16(v0[2], v0[3]); w.z = cvt_pk_bf16(v1[0], v1[1]); w.w = cvt_pk_bf16(v1[2], v1[3]);
                            if (br < 2) scr[soff + (mm * 2 + bj) * 512] = w;
                            else *(u32x4*)(merged + (size_t)row * D + col) = w;
                        }
                    }
                soff += 2048u; asm volatile("" : "+v"(soff) :: "memory");
            }
    }
};
__device__ __forceinline__ void g2_tail_reduce(const float* part, int pieces, bf16_t* merged) {
    const int tid = opaque_tid(); const int pn = (4 * tid) >> 8, cc = (4 * tid) & 255;
    for (int R = blockIdx.x; R < 256; R += gridDim.x) {
        f32x4 a = (f32x4){0.f, 0.f, 0.f, 0.f};
        for (int k = 0; k < 3 * pieces; ++k) a += *(const f32x4*)(part + (size_t)(pn * 3 * pieces + k) * 65536 + (size_t)R * 256 + cc);
        *(u32x2*)(merged + (size_t)(MP - 256 + R) * D + 4 * tid) = (u32x2){cvt_pk_bf16(a.x, a.y), cvt_pk_bf16(a.z, a.w)};
    }
}
struct EpiMix {
    static constexpr bool PERM = true;
    bf16_t* C; int ldc; float* part; int pieces;
    __device__ __forceinline__ void operator()(const Acc& acc, const Unit& u, int wr, int wc, int fr, int fq) const {
        const int r0 = wr * 64 + fr;
#pragma unroll
        for (int ai = 0; ai < 2; ++ai)
#pragma unroll
            for (int m = 0; m < 4; ++m) { const int r = r0 + ai * 128 + m * 16;
#pragma unroll
                for (int bj = 0; bj < 2; ++bj) { const int colt = bj * 128 + wc * 32 + 8 * fq; const f32x4 v0 = acc[ai][bj][m][0], v1 = acc[ai][bj][m][1];
                    if (u.aux == 0) { u32x4 w; w.x = cvt_pk_bf16(v0[0], v0[1]); w.y = cvt_pk_bf16(v0[2], v0[3]); w.z = cvt_pk_bf16(v1[0], v1[1]); w.w = cvt_pk_bf16(v1[2], v1[3]);
                        *(u32x4*)(C + (size_t)(u.pm * 256 + r) * ldc + u.pn * 256 + colt) = w; }
                    else { float* d = part + (size_t)(u.pn * pieces + (u.aux - 1)) * 65536 + (size_t)r * 256 + colt; *(f32x4*)d = v0; *(f32x4*)(d + 4) = v1; } }
                asm volatile("" ::: "memory"); }
    }
};
struct EpiSwiglu {
    static constexpr bool PERM = true;
    bf16_t* hid;
    __device__ __forceinline__ void operator()(const Acc& acc, const Unit& u, int wr, int wc, int fr, int fq) const {
        const int row0 = u.pm * 256 + wr * 64 + fr; const int col = u.pn * 128 + wc * 32 + 8 * fq;
#pragma unroll
        for (int ai = 0; ai < 2; ++ai)
#pragma unroll
            for (int m = 0; m < 4; ++m) {
                float o[8];
#pragma unroll
                for (int j = 0; j < 8; ++j) { const float g = acc[ai][0][m][j >> 2][j & 3], up = acc[ai][1][m][j >> 2][j & 3]; o[j] = g * sigmoidf_(g) * up; }
                u32x4 w; w.x = cvt_pk_bf16(o[0], o[1]); w.y = cvt_pk_bf16(o[2], o[3]); w.z = cvt_pk_bf16(o[4], o[5]); w.w = cvt_pk_bf16(o[6], o[7]);
                *(u32x4*)(hid + (size_t)(row0 + ai * 128 + m * 16) * DFF + col) = w;
            }
    }
};
}

template <int MAPMODE>
__device__ __forceinline__ void transpose_item(const float* W, int K, int N, bf16_t* WT, int item, int sub, int lane) {
    const int nblk = N / 256, kb = item / nblk, nb = item - kb * nblk, n = 256 * nb + 4 * lane;
    int nn = n;
    if (MAPMODE == 1) { if (nn < DFF) nn = 256 * (nn >> 7) + (nn & 127); else { const int q = nn - DFF; nn = 256 * (q >> 7) + 128 + (q & 127); } }
    {
        const int k0 = 64 * kb + 16 * sub;
        f32x4 r[16];
#pragma unroll
        for (int e = 0; e < 16; ++e) r[e] = *(const f32x4*)(W + (size_t)(k0 + e) * N + n);
#pragma unroll
        for (int j = 0; j < 4; ++j) {
            u32x4 o0, o1;
            o0.x = cvt_pk_bf16(r[0][j], r[1][j]); o0.y = cvt_pk_bf16(r[2][j], r[3][j]); o0.z = cvt_pk_bf16(r[4][j], r[5][j]); o0.w = cvt_pk_bf16(r[6][j], r[7][j]);
            o1.x = cvt_pk_bf16(r[8][j], r[9][j]); o1.y = cvt_pk_bf16(r[10][j], r[11][j]); o1.z = cvt_pk_bf16(r[12][j], r[13][j]); o1.w = cvt_pk_bf16(r[14][j], r[15][j]);
            bf16_t* d = WT + (size_t)(nn + j) * K + k0;
            *(u32x4*)d = o0; *(u32x4*)(d + 8) = o1;
        }
    }
}

__device__ __forceinline__ void s5_gen_task(LAS unsigned char* lds, int g, int qd, const float* lam_re, const float* lam_im, const float* b_re, const float* b_im,
                                            const float* c_re, const float* c_im, const float* log_step, bf16_t* TPm, bf16_t* W1) {
    LAS float* pwr = (LAS float*)lds;
    LAS float* pwi = pwr + 33 * 64;
    LAS float* bbr = pwi + 33 * 64;
    LAS float* bbi = bbr + 1024;
    LAS float* cr = bbi + 1024;
    LAS float* ci = cr + 1024;
    LAS float* Kt = ci + 1024;
    const int tid = opaque_tid();
    __syncthreads();
    {
        const int p = tid & 63, ds = tid >> 6; const float lr = lam_re[g * 64 + p], li = lam_im[g * 64 + p], step = expf(log_step[g]);
        for (int d = ds; d <= 32; d += 8) { const float mag = expf((float)d * lr * step); float s_, c_; sincosf((float)d * li * step, &s_, &c_); pwr[d * 64 + p] = mag * c_; pwi[d * 64 + p] = mag * s_; }
        if (ds == 0) {
            const float mag = expf(lr * step); float s_, c_; sincosf(li * step, &s_, &c_); const float ar = mag * c_, aim = mag * s_;
            const float den = lr * lr + li * li; const float cre = ((ar - 1.0f) * lr + aim * li) / den, cim = (aim * lr - (ar - 1.0f) * li) / den;
            for (int cc = 0; cc < 16; ++cc) { const float br = b_re[((size_t)g * 64 + p) * 16 + cc], bi = b_im[((size_t)g * 64 + p) * 16 + cc];
                bbr[p * 16 + cc] = cre * br - cim * bi; bbi[p * 16 + cc] = cre * bi + cim * br; }
        }
    }
    for (int i = tid; i < 1024; i += 512) { cr[i] = c_re[(size_t)g * 1024 + i]; ci[i] = c_im[(size_t)g * 1024 + i]; }
    __syncthreads();
    for (int e = tid; e < 2048; e += 512) {
        const int d = e >> 6, col = (e >> 4) & 3, co = 4 * qd + col, cin = e & 15; float a = 0.f;
        for (int p = 0; p < 64; ++p) { const float pr = pwr[d * 64 + p], pi = pwi[d * 64 + p], br = bbr[p * 16 + cin], bi = bbi[p * 16 + cin];
            const float er = pr * br - pi * bi, ei = pr * bi + pi * br; a += cr[co * 64 + p] * er - ci[co * 64 + p] * ei; }
        Kt[e] = a;
    }
    __syncthreads();
    bf16_t* tp = TPm + (size_t)g * 512 * XLD;
    for (int q = tid; q < 128 * 80; q += 512) {
        const int nl = q / 80, kc = q - nl * 80, k0 = kc * 8; const int i = nl >> 2, col = nl & 3, co = 4 * qd + col, n = i * 16 + co; float v[8];
        if (k0 < 512) { const int j = k0 >> 4, cin0 = k0 & 15;
#pragma unroll
            for (int e = 0; e < 8; ++e) v[e] = (j <= i) ? Kt[(i - j) * 64 + col * 16 + cin0 + e] : 0.f;
        } else { const int p0 = (k0 - 512) >> 1;
#pragma unroll
            for (int e = 0; e < 4; ++e) { const int p = p0 + e; const float pr = pwr[(i + 1) * 64 + p], pi = pwi[(i + 1) * 64 + p], c_r = cr[co * 64 + p], c_i = ci[co * 64 + p];
                v[2 * e] = c_r * pr - c_i * pi; v[2 * e + 1] = -(c_r * pi + c_i * pr); }
        }
        u32x4 w; w.x = cvt_pk_bf16(v[0], v[1]); w.y = cvt_pk_bf16(v[2], v[3]); w.z = cvt_pk_bf16(v[4], v[5]); w.w = cvt_pk_bf16(v[6], v[7]);
        *(u32x4*)(tp + (size_t)n * XLD + k0) = w;
    }
    bf16_t* w1 = W1 + (size_t)g * 128 * 512;
    for (int q = tid; q < 32 * 64; q += 512) {
        const int n = 32 * qd + (q >> 6), kc = q & 63, k0 = kc * 8; const int p = n >> 1, r = n & 1; const int j = k0 >> 4, cin0 = k0 & 15; float v[8];
        const float pr = pwr[(31 - j) * 64 + p], pi = pwi[(31 - j) * 64 + p];
#pragma unroll
        for (int e = 0; e < 8; ++e) { const float br = bbr[p * 16 + cin0 + e], bi = bbi[p * 16 + cin0 + e]; v[e] = r ? (pr * bi + pi * br) : (pr * br - pi * bi); }
        u32x4 w; w.x = cvt_pk_bf16(v[0], v[1]); w.y = cvt_pk_bf16(v[2], v[3]); w.z = cvt_pk_bf16(v[4], v[5]); w.w = cvt_pk_bf16(v[6], v[7]);
        *(u32x4*)(w1 + (size_t)n * 512 + k0) = w;
    }
    __syncthreads();
}

#define GASF const __attribute__((address_space(1))) float
__device__ __forceinline__ void phase_norm(const Params& P, int mode, const bf16_t* src, const float* w_add, const float* w_norm, bf16_t* hbuf, bf16_t* xsb, const float* part, int pieces) {
    const int tid_ = opaque_tid(); const int lane = tid_ & 63, wave = tid_ >> 6; const int gw = blockIdx.x * 8 + wave, NGW = gridDim.x * 8;
    for (int m = gw; m < MP; m += NGW) {
        const int b = m / TP, tp = m - b * TP;
        u32x2* hrow = (u32x2*)(hbuf + (size_t)m * D) + lane;
        if (tp < PADT) { if (mode != 2) {
#pragma unroll
                for (int j = 0; j < 8; ++j) hrow[64 * j] = (u32x2){0u, 0u}; }
            continue; }
        if (mode == 2 && tp < 64) continue;
        f32x4 v[8];
        if (mode == 0 || mode == 3) {
            GASF* s0 = (tp < 64) ? (GASF*)P.in[I_META] + (size_t)(tp - PADT) * D : (GASF*)P.in[I_X] + ((size_t)b * SEQ + (tp - 64)) * D;
#pragma unroll
            for (int j = 0; j < 8; ++j) v[j] = ((const __attribute__((address_space(1))) f32x4*)s0)[lane + 64 * j];
        } else {
#pragma unroll
            for (int j = 0; j < 8; ++j) { const u32x2 w = ((const u32x2*)(xsb + (size_t)m * D))[lane + 64 * j]; v[j] = (f32x4){bf_lo(w.x), bf_hi(w.x), bf_lo(w.y), bf_hi(w.y)}; }
        }
        if (mode != 0) {
            f32x4 s[8]; float ss = 0.f;
            if (m < MP - 256) {
#pragma unroll
                for (int j = 0; j < 8; ++j) { const u32x2 w = ((const u32x2*)(src + (size_t)m * D))[lane + 64 * j]; s[j] = (f32x4){bf_lo(w.x), bf_hi(w.x), bf_lo(w.y), bf_hi(w.y)}; }
            } else {
#pragma unroll
                for (int j = 0; j < 8; ++j) s[j] = (f32x4){0.f, 0.f, 0.f, 0.f};
#pragma unroll 2
                for (int pc = 0; pc < pieces; ++pc) {
#pragma unroll
                    for (int j = 0; j < 8; ++j) s[j] += ((const f32x4*)(part + ((size_t)(j * pieces + pc) * 256 + (m - (MP - 256))) * 256))[lane];
                }
            }
#pragma unroll
            for (int j = 0; j < 8; ++j) ss += (s[j].x * s[j].x + s[j].y * s[j].y) + (s[j].z * s[j].z + s[j].w * s[j].w);
            const float r = rsqrtf(wave_sum(ss) * (1.0f / D) + 1e-6f);
#pragma unroll
            for (int j = 0; j < 8; ++j) { const f32x4 w = ((const f32x4*)w_add)[lane + 64 * j]; v[j] += s[j] * r * w; }
            if (mode == 2) {
                __attribute__((address_space(1))) f32x4* o = (__attribute__((address_space(1))) f32x4*)((__attribute__((address_space(1))) float*)P.out + ((size_t)b * SEQ + (tp - 64)) * D);
#pragma unroll
                for (int j = 0; j < 8; ++j) o[lane + 64 * j] = v[j];
                continue;
            }
#pragma unroll
            for (int j = 0; j < 8; ++j) ((u32x2*)(xsb + (size_t)m * D))[lane + 64 * j] = (u32x2){cvt_pk_bf16(v[j].x, v[j].y), cvt_pk_bf16(v[j].z, v[j].w)};
        }
        float ss = 0.f;
#pragma unroll
        for (int j = 0; j < 8; ++j) ss += (v[j].x * v[j].x + v[j].y * v[j].y) + (v[j].z * v[j].z + v[j].w * v[j].w);
        const float r = rsqrtf(wave_sum(ss) * (1.0f / D) + 1e-6f);
#pragma unroll
        for (int j = 0; j < 8; ++j) { const f32x4 w = ((const f32x4*)w_norm)[lane + 64 * j]; const f32x4 o = v[j] * r * w;
            hrow[64 * j] = (u32x2){cvt_pk_bf16(o.x, o.y), cvt_pk_bf16(o.z, o.w)}; }
    }
}

__device__ __forceinline__ void phase_prep(LAS unsigned char* lds, const bf16_t* p5, bf16_t* xc, bf16_t* vt, const float* cw, const float* cb) {
    const int tid = opaque_tid(); const int gt = blockIdx.x * 512 + tid, NGT = gridDim.x * 512;
    for (int it = gt; it < MP * 128; it += NGT) {
        const int m = it >> 7, c0 = (it & 127) * 8; float o[8];
#pragma unroll
        for (int j = 0; j < 8; ++j) o[j] = cb[c0 + j];
#pragma unroll
        for (int k = 0; k < 4; ++k) { const int mm = m - 3 + k; if (mm >= 0) {
                const u32x4 a = *(const u32x4*)(p5 + (size_t)mm * LDP + C_AX + c0);
                const float av[8] = {bf_lo(a.x), bf_hi(a.x), bf_lo(a.y), bf_hi(a.y), bf_lo(a.z), bf_hi(a.z), bf_lo(a.w), bf_hi(a.w)};
#pragma unroll
                for (int j = 0; j < 8; ++j) o[j] += cw[k * 1024 + c0 + j] * av[j]; } }
        u32x4 w; w.x = cvt_pk_bf16(o[0], o[1]); w.y = cvt_pk_bf16(o[2], o[3]); w.z = cvt_pk_bf16(o[4], o[5]); w.w = cvt_pk_bf16(o[6], o[7]);
        *(u32x4*)(xc + (size_t)m * 1024 + c0) = w;
    }
    LAS bf16_t* tl = (LAS bf16_t*)lds;
    for (int it = blockIdx.x; it < 32 * 65; it += gridDim.x) {
        const int bh = it / 65, tb = it - bh * 65, b = bh >> 3, h = bh & 7;
        __syncthreads();
#pragma unroll
        for (int i = 0; i < 2; ++i) { const int id = tid + 512 * i, row = id >> 4, c16 = id & 15;
            const u32x4 a = *(const u32x4*)(p5 + ((size_t)b * TP + tb * 64 + row) * LDP + C_V + h * 128 + c16 * 8);
            LAS unsigned* d = (LAS unsigned*)(tl + row * 130 + c16 * 8); d[0] = a.x; d[1] = a.y; d[2] = a.z; d[3] = a.w; }
        __syncthreads();
#pragma unroll
        for (int i = 0; i < 2; ++i) { const int id = tid + 512 * i, dv = id >> 3, c8 = id & 7; unsigned short e[8];
#pragma unroll
            for (int j = 0; j < 8; ++j) e[j] = tl[(c8 * 8 + j) * 130 + dv];
            u32x4 w; w.x = e[0] | ((unsigned)e[1] << 16); w.y = e[2] | ((unsigned)e[3] << 16); w.z = e[4] | ((unsigned)e[5] << 16); w.w = e[6] | ((unsigned)e[7] << 16);
            *(u32x4*)(vt + ((size_t)bh * 128 + dv) * TP + tb * 64 + c8 * 8) = w; }
    }
    __syncthreads();
}

__device__ __forceinline__ void lru_scan1(const bf16_t* p5, const bf16_t* bbuf, float* agg) {
    const int gt = blockIdx.x * 512 + opaque_tid(), NGT = gridDim.x * 512;
    for (int it = gt; it < NB * NCH64 * 512; it += NGT) {
        const int cp = it & 511, bc = it >> 9; const int b = bc / NCH64, c = bc - b * NCH64; const size_t m0 = (size_t)b * TP + c * 64;
        float s0 = 0.f, s1 = 0.f, h0 = 0.f, h1 = 0.f;
        for (int t0 = 0; t0 < 64; t0 += 32) {
            unsigned lw[32], bw[32];
#pragma unroll
            for (int k = 0; k < 32; ++k) { lw[k] = *(const unsigned*)(p5 + (m0 + t0 + k) * LDP + C_AX + 2 * cp); bw[k] = *(const unsigned*)(bbuf + (m0 + t0 + k) * 1024 + 2 * cp); }
#pragma unroll
            for (int k = 0; k < 32; ++k) { const float l0 = bf_lo(lw[k]), l1 = bf_hi(lw[k]); s0 += l0; s1 += l1; h0 = __expf(l0) * h0 + bf_lo(bw[k]); h1 = __expf(l1) * h1 + bf_hi(bw[k]); }
        }
        *(f32x4*)(agg + ((size_t)bc * 512 + cp) * 4) = (f32x4){s0, h0, s1, h1};
    }
}
__device__ __forceinline__ void lru_scan2(bf16_t* p5, const bf16_t* bbuf, const float* agg) {
    const int gt = blockIdx.x * 512 + opaque_tid(), NGT = gridDim.x * 512;
    for (int it = gt; it < NB * NCH64 * 512; it += NGT) {
        const int cp = it & 511, bc = it >> 9; const int b = bc / NCH64, c = bc - b * NCH64; const size_t m0 = (size_t)b * TP + c * 64;
        float h0 = 0.f, h1 = 0.f;
        for (int cc0 = 0; cc0 < c; cc0 += 16) {
            f32x4 a[16];
#pragma unroll
            for (int k = 0; k < 16; ++k) a[k] = (cc0 + k < c) ? *(const f32x4*)(agg + ((size_t)(b * NCH64 + cc0 + k) * 512 + cp) * 4) : (f32x4){0.f, 0.f, 0.f, 0.f};
#pragma unroll
            for (int k = 0; k < 16; ++k) { h0 = __expf(a[k].x) * h0 + a[k].y; h1 = __expf(a[k].z) * h1 + a[k].w; }
        }
        for (int t0 = 0; t0 < 64; t0 += 16) {
            unsigned lw[16], bw[16], gw[16];
#pragma unroll
            for (int k = 0; k < 16; ++k) { lw[k] = *(const unsigned*)(p5 + (m0 + t0 + k) * LDP + C_AX + 2 * cp); bw[k] = *(const unsigned*)(bbuf + (m0 + t0 + k) * 1024 + 2 * cp);
                gw[k] = *(const unsigned*)(p5 + (m0 + t0 + k) * LDP + C_AG + 2 * cp); }
#pragma unroll
            for (int k = 0; k < 16; ++k) { h0 = __expf(bf_lo(lw[k])) * h0 + bf_lo(bw[k]); h1 = __expf(bf_hi(lw[k])) * h1 + bf_hi(bw[k]);
                gw[k] = cvt_pk_bf16(h0 * gelu_tanh(bf_lo(gw[k])), h1 * gelu_tanh(bf_hi(gw[k]))); }
#pragma unroll
            for (int k = 0; k < 16; ++k) *(unsigned*)(p5 + (m0 + t0 + k) * LDP + C_AG + 2 * cp) = gw[k];
        }
    }
}
__device__ __forceinline__ void s5_carry(bf16_t* xh, const float* sb, const float* lam_re, const float* lam_im, const float* log_step) {
    const int gt = blockIdx.x * 512 + opaque_tid(), NGT = gridDim.x * 512;
    for (int it = gt; it < NB * 64 * 64; it += NGT) {
        const int p = it & 63, g = (it >> 6) & 63, b = it >> 12;
        const float lr = lam_re[g * 64 + p], li = lam_im[g * 64 + p], step = expf(log_step[g]);
        const float mag = expf(32.0f * lr * step); float s, c; sincosf(32.0f * li * step, &s, &c); const float ar = mag * c, ai = mag * s;
        float hr = 0.f, hi = 0.f;
        for (int ch0 = 0; ch0 < NCH32; ch0 += 26) {
            const size_t row0 = (size_t)g * XROWS + b * NCH32 + ch0; f32x2 sv[26];
#pragma unroll
            for (int k = 0; k < 26; ++k) sv[k] = *(const f32x2*)(sb + (row0 + k) * 128 + 2 * p);
#pragma unroll
            for (int k = 0; k < 26; ++k) {
                *(unsigned*)(xh + (row0 + k) * XLD + 512 + 2 * p) = cvt_pk_bf16(hr, hi);
                const float nr = ar * hr - ai * hi + sv[k].x, ni = ar * hi + ai * hr + sv[k].y; hr = nr; hi = ni; }
        }
    }
}

__device__ __forceinline__ float rows4_max(float v) {
    unsigned a = __float_as_uint(v); auto r = __builtin_amdgcn_permlane16_swap(a, a, false, false); v = fmaxf(__uint_as_float(r[0]), __uint_as_float(r[1]));
    a = __float_as_uint(v); auto r2 = __builtin_amdgcn_permlane32_swap(a, a, false, false); return fmaxf(__uint_as_float(r2[0]), __uint_as_float(r2[1])); }
__device__ __forceinline__ float rows4_sum(float v) {
    unsigned a = __float_as_uint(v); auto r = __builtin_amdgcn_permlane16_swap(a, a, false, false); v = __uint_as_float(r[0]) + __uint_as_float(r[1]);
    a = __float_as_uint(v); auto r2 = __builtin_amdgcn_permlane32_swap(a, a, false, false); return __uint_as_float(r2[0]) + __uint_as_float(r2[1]); }
constexpr int KPITCH = 272, VPITCH = 144, KBYTES = 64 * KPITCH, VBYTES = 128 * VPITCH;
__device__ __forceinline__ void attn_phase(LAS unsigned char* lds, bf16_t* p5, const bf16_t* vt, const float* relb, const float* dalam, const float* subln, float lam_init, int ocol) {
    const int tid = opaque_tid(), lane = tid & 63, wave = __builtin_amdgcn_readfirstlane(tid >> 6), lq = lane & 15, g4 = lane >> 4;
    const int cc = wave & 1, rgi = wave >> 1;
    LAS float* btab = (LAS float*)(lds + 2 * KBYTES + 2 * VBYTES);
    float lam;
    { float s1 = 0.f, s2 = 0.f; for (int i = 0; i < 64; ++i) { s1 += dalam[i] * dalam[64 + i]; s2 += dalam[128 + i] * dalam[192 + i]; } lam = expf(s1) - expf(s2) + lam_init; }
    const int c = blockIdx.x, G = gridDim.x;
    const float sc2 = 0.125f * LOG2E;
    for (int r = 0;; ++r) {
        const int idx = (r & 1) ? r * G + (G - 1 - c) : r * G + c;
        if (r * G >= 33 * 32) break;
        if (idx >= 33 * 32) continue;
        const int qt = 32 - idx / 32, bh = idx & 31, b = bh >> 3, h = bh & 7;
        const int njt = (2 * qt + 2) < 65 ? (2 * qt + 2) : 65;
        const int qrow0 = qt * 128 + rgi * 32;
        __syncthreads();
        if (tid < 128) { const int d = tid; int bk = d; if (d >= 16) { bk = 16 + (int)(logf((float)d * (1.0f / 16.0f)) * (16.0f / logf(8.0f))); if (bk > 31) bk = 31; } btab[d] = relb[bk * 8 + h] * LOG2E; }
        const float bfar = relb[31 * 8 + h] * LOG2E;
        bf16x8 qf[2][2];
#pragma unroll
        for (int rg = 0; rg < 2; ++rg) { const int q = qrow0 + 16 * rg + lq, qc = q < TP ? q : TP - 1;
#pragma unroll
            for (int s = 0; s < 2; ++s) qf[rg][s] = *(const bf16x8*)(p5 + ((size_t)b * TP + qc) * LDP + C_Q + h * 128 + cc * 64 + s * 32 + 8 * g4); }
        f32x4 O[2][8]; float mrow[2], lrow[2];
#pragma unroll
        for (int rg = 0; rg < 2; ++rg) { mrow[rg] = -INFINITY; lrow[rg] = 0.f;
#pragma unroll
            for (int k = 0; k < 8; ++k) O[rg][k] = (f32x4){0.f, 0.f, 0.f, 0.f}; }
        u32x4 kreg[2], vreg[2];
        const bf16_t* kbase = p5 + (size_t)b * TP * LDP + C_K + h * 128; const bf16_t* vbase = vt + (size_t)bh * 128 * TP;
#define ATT_LOAD(j) do { _Pragma("unroll") for (int i = 0; i < 2; ++i) { const int id = tid + 512 * i; \
            kreg[i] = *(const u32x4*)(kbase + (size_t)((j) * 64 + (id >> 4)) * LDP + (id & 15) * 8); \
            vreg[i] = *(const u32x4*)(vbase + (size_t)(id >> 3) * TP + (j) * 64 + (id & 7) * 8); } } while (0)
#define ATT_STORE(buf) do { _Pragma("unroll") for (int i = 0; i < 2; ++i) { const int id = tid + 512 * i; \
            *(LAS u32x4*)(lds + (buf) * KBYTES + (id >> 4) * KPITCH + (id & 15) * 16) = kreg[i]; \
            *(LAS u32x4*)(lds + 2 * KBYTES + (buf) * VBYTES + (id >> 3) * VPITCH + (id & 7) * 16) = vreg[i]; } } while (0)
        ATT_LOAD(0); ATT_STORE(0); __syncthreads();
        for (int j = 0; j < njt; ++j) {
            if (j + 1 < njt) ATT_LOAD(j + 1);
            if (j * 64 <= qrow0 + 31) {
                const LAS unsigned char* kb_ = lds + (j & 1) * KBYTES; const LAS unsigned char* vb_ = lds + 2 * KBYTES + (j & 1) * VBYTES;
                bf16x8 kf[4][2];
#pragma unroll
                for (int kb = 0; kb < 4; ++kb)
#pragma unroll
                    for (int s = 0; s < 2; ++s) kf[kb][s] = *(const LAS bf16x8*)(kb_ + (16 * kb + lq) * KPITCH + (cc * 64 + s * 32 + 8 * g4) * 2);
                __builtin_amdgcn_sched_barrier(0);
                f32x4 st[2][4];
#pragma unroll
                for (int kb = 0; kb < 4; ++kb)
#pragma unroll
                    for (int rg = 0; rg < 2; ++rg) { f32x4 a = (f32x4){0.f, 0.f, 0.f, 0.f};
#pragma unroll
                        for (int s = 0; s < 2; ++s) a = __builtin_amdgcn_mfma_f32_16x16x32_bf16(kf[kb][s], qf[rg][s], a, 0, 0, 0);
                        st[rg][kb] = a; }
                __builtin_amdgcn_sched_barrier(0);
#define ATT_VLOAD(dst, k0, nk) _Pragma("unroll") for (int k = 0; k < (nk); ++k) _Pragma("unroll") for (int s = 0; s < 2; ++s) { \
                    const LAS unsigned char* vp = vb_ + (16 * (k + (k0)) + lq) * VPITCH + (32 * s + 4 * g4) * 2; dst[k][s][0] = *(const LAS u32x2*)vp; dst[k][s][1] = *(const LAS u32x2*)(vp + 32); }
#define ATT_PV(src, k0, nk) _Pragma("unroll") for (int k = 0; k < (nk); ++k) _Pragma("unroll") for (int s = 0; s < 2; ++s) { \
                    const bf16x8 vf = __builtin_bit_cast(bf16x8, (u32x4){src[k][s][0].x, src[k][s][0].y, src[k][s][1].x, src[k][s][1].y}); \
                    O[0][k + (k0)] = __builtin_amdgcn_mfma_f32_16x16x32_bf16(vf, pk[0][s], O[0][k + (k0)], 0, 0, 0); \
                    O[1][k + (k0)] = __builtin_amdgcn_mfma_f32_16x16x32_bf16(vf, pk[1][s], O[1][k + (k0)], 0, 0, 0); }
                u32x2 va[1][2][2];
                ATT_VLOAD(va, 0, 1)
                __builtin_amdgcn_sched_barrier(0);
                const bool far = (j >= 1) && (j * 64 + 63 + 113 <= qrow0);
                bf16x8 pk[2][2];
#pragma unroll
                for (int rg = 0; rg < 2; ++rg) {
                    float rmax = -INFINITY, msafe, alpha;
                    if (far) {
#pragma unroll
                        for (int kb = 0; kb < 4; ++kb)
#pragma unroll
                            for (int i = 0; i < 4; ++i) rmax = fmaxf(rmax, st[rg][kb][i]);
                        rmax = rows4_max(rmax);
                        const float mnew = fmaxf(mrow[rg], rmax * sc2 + bfar); msafe = mnew;
                        alpha = __builtin_amdgcn_exp2f(mrow[rg] - msafe); mrow[rg] = mnew;
                        const float off = bfar - msafe;
#pragma unroll
                        for (int kb = 0; kb < 4; ++kb)
#pragma unroll
                            for (int i = 0; i < 4; ++i) st[rg][kb][i] = __builtin_amdgcn_exp2f(st[rg][kb][i] * sc2 + off);
                    } else {
                        const int q = qrow0 + 16 * rg + lq;
#pragma unroll
                        for (int kb = 0; kb < 4; ++kb)
#pragma unroll
                            for (int i = 0; i < 4; ++i) { float v = st[rg][kb][i] * sc2;
                                const int kp = j * 64 + 16 * kb + 4 * g4 + i; const int dist = q - kp;
                                const float bv = (dist >= 0 && dist < 128) ? btab[dist] : bfar;
                                v = (kp >= PADT && dist >= 0) ? v + bv : -INFINITY;
                                st[rg][kb][i] = v; rmax = fmaxf(rmax, v); }
                        rmax = rows4_max(rmax);
                        const float mnew = fmaxf(mrow[rg], rmax); msafe = (mnew == -INFINITY) ? 0.f : mnew;
                        alpha = __builtin_amdgcn_exp2f(mrow[rg] - msafe); mrow[rg] = mnew;
#pragma unroll
                        for (int kb = 0; kb < 4; ++kb)
#pragma unroll
                            for (int i = 0; i < 4; ++i) st[rg][kb][i] = __builtin_amdgcn_exp2f(st[rg][kb][i] - msafe);
                    }
                    float rs = 0.f;
#pragma unroll
                    for (int kb = 0; kb < 4; ++kb) rs += (st[rg][kb][0] + st[rg][kb][1]) + (st[rg][kb][2] + st[rg][kb][3]);
                    lrow[rg] = lrow[rg] * alpha + rs;
                    if (__builtin_amdgcn_ballot_w64(alpha != 1.0f) != 0ull) {
#pragma unroll
                        for (int k = 0; k < 8; ++k) O[rg][k] *= alpha; }
#pragma unroll
                    for (int s = 0; s < 2; ++s) { u32x4 w; w.x = cvt_pk_bf16(st[rg][2 * s][0], st[rg][2 * s][1]); w.y = cvt_pk_bf16(st[rg][2 * s][2], st[rg][2 * s][3]);
                        w.z = cvt_pk_bf16(st[rg][2 * s + 1][0], st[rg][2 * s + 1][1]); w.w = cvt_pk_bf16(st[rg][2 * s + 1][2], st[rg][2 * s + 1][3]);
                        pk[rg][s] = __builtin_bit_cast(bf16x8, w); }
                }
                __builtin_amdgcn_sched_barrier(0);
                u32x2 vc[3][2][2];
                ATT_VLOAD(vc, 1, 3)
                __builtin_amdgcn_sched_barrier(0);
                ATT_PV(va, 0, 1)
                __builtin_amdgcn_sched_barrier(0);
                u32x2 vd[2][2][2];
                ATT_VLOAD(vd, 4, 2)
                __builtin_amdgcn_sched_barrier(0);
                ATT_PV(vc, 1, 3)
                __builtin_amdgcn_sched_barrier(0);
                u32x2 ve[2][2][2];
                ATT_VLOAD(ve, 6, 2)
                __builtin_amdgcn_sched_barrier(0);
                ATT_PV(vd, 4, 2)
                __builtin_amdgcn_sched_barrier(0);
                ATT_PV(ve, 6, 2)
#undef ATT_VLOAD
#undef ATT_PV
            }
            if (j + 1 < njt) ATT_STORE((j + 1) & 1);
            __syncthreads();
        }
#undef ATT_LOAD
#undef ATT_STORE
        LAS f32x4* xch = (LAS f32x4*)lds + (size_t)rgi * 2 * 8 * 64 + lane;
#pragma unroll
        for (int rg = 0; rg < 2; ++rg) { const float l_ = rows4_sum(lrow[rg]); const float f = l_ > 0.f ? (cc ? lam : 1.0f) / l_ : 0.f;
#pragma unroll
            for (int k = 0; k < 8; ++k) { O[rg][k] *= f; if (cc) xch[(rg * 8 + k) * 64] = O[rg][k]; } }
        __syncthreads();
        if (cc == 0) {
#pragma unroll
            for (int rg = 0; rg < 2; ++rg) { const int q = qrow0 + 16 * rg + lq; float ss = 0.f;
#pragma unroll
                for (int k = 0; k < 8; ++k) { O[rg][k] -= xch[(rg * 8 + k) * 64]; ss += (O[rg][k].x * O[rg][k].x + O[rg][k].y * O[rg][k].y) + (O[rg][k].z * O[rg][k].z + O[rg][k].w * O[rg][k].w); }
                ss = rows4_sum(ss);
                const float rn = rsqrtf(ss * (1.0f / 128.0f) + 1e-5f) * (1.0f - lam_init);
                if (q < TP) {
#pragma unroll
                    for (int k = 0; k < 8; ++k) { const f32x4 w = *(const f32x4*)(subln + 16 * k + 4 * g4); const f32x4 o = O[rg][k] * rn * w;
                        *(u32x2*)(p5 + ((size_t)b * TP + q) * LDP + ocol + h * 128 + 16 * k + 4 * g4) = (u32x2){cvt_pk_bf16(o.x, o.y), cvt_pk_bf16(o.z, o.w)}; }
                }
            }
        }
    }
    __syncthreads();
}

#define XB_TMO      128
#define XB_XCNT(j)  (256  + 64 * (j))
#define XB_XSUB(j)  (1280 + 64 * (j))
#define XB_XGEN(j)  (2304 + 64 * (j))
#define XB_TOP      3328
#define XB_TOPGEN   3392
#define XCD_BAR_WORDS 3456
#define XB_SPIN_CAP (1u << 20)
__device__ __forceinline__ unsigned xb_ld(unsigned* p)              { return __hip_atomic_load(p, __ATOMIC_RELAXED, __HIP_MEMORY_SCOPE_AGENT); }
__device__ __forceinline__ unsigned xb_add(unsigned* p, unsigned v) { return __hip_atomic_fetch_add(p, v, __ATOMIC_RELAXED, __HIP_MEMORY_SCOPE_AGENT); }
__device__ __forceinline__ unsigned xb_xcc_id() { return (unsigned)__builtin_amdgcn_s_getreg((3 << 11) | 20) & 0xFu; }
#define XB_SPIN(cond, bar) do { unsigned _sp = 0; while (cond) { __builtin_amdgcn_s_sleep(1); \
    if ((++_sp & 255u) == 0u) { if (xb_ld(&(bar)[XB_TMO])) break; if (_sp > XB_SPIN_CAP) { atomicAdd(&(bar)[XB_TMO], 1u); break; } } } } while (0)
struct XcdBarrier { unsigned* bar; unsigned x; volatile LAS unsigned* st; };
__device__ __forceinline__ XcdBarrier xcd_barrier_post(unsigned* bar, volatile LAS unsigned* st) {
    XcdBarrier b; b.bar = bar; b.x = xb_xcc_id(); b.st = st;
    if (threadIdx.x == 0) (void)xb_add(&bar[XB_XCNT(b.x)], 1u);
    return b;
}
__device__ __forceinline__ void xcd_barrier_complete(unsigned* bar, unsigned x, unsigned& nloc, unsigned& nx) {
    const unsigned G = gridDim.x * gridDim.y * gridDim.z;
    unsigned sum, cnt, mine, sp = 0u;
    for (;;) {
        sum = 0u; cnt = 0u; mine = 0u;
#pragma unroll
        for (unsigned j = 0; j < 16; ++j) { const unsigned c = xb_ld(&bar[XB_XCNT(j)]); sum += c; cnt += (c > 0u) ? 1u : 0u; mine = (j == x) ? c : mine; }
        if (sum == G) break;
        __builtin_amdgcn_s_sleep(1);
        if ((++sp & 255u) == 0u) { if (xb_ld(&bar[XB_TMO])) break; if (sp > XB_SPIN_CAP) { atomicAdd(&bar[XB_TMO], 1u); break; } }
    }
    nloc = mine > 0u ? mine : 1u; nx = cnt > 0u ? cnt : 1u;
}
__device__ __forceinline__ void xcd_barrier(const XcdBarrier& b) {
    asm volatile("s_waitcnt vmcnt(0)" ::: "memory");
    __syncthreads();
    if (threadIdx.x == 0) {
        unsigned* bar = b.bar;
        __builtin_amdgcn_s_waitcnt(0);
        unsigned nloc = b.st[0], nx = b.st[1];
        if (nloc == 0u) { xcd_barrier_complete(bar, b.x, nloc, nx); b.st[0] = nloc; b.st[1] = nx; }
        const unsigned old = xb_add(&bar[XB_XSUB(b.x)], 1u);
        const unsigned gen = old / nloc;
        if (old + 1u == (gen + 1u) * nloc) {
            __builtin_amdgcn_fence(__ATOMIC_RELEASE, "agent");
            asm volatile("s_waitcnt vmcnt(0)" ::: "memory");
            const unsigned og = xb_add(&bar[XB_TOP], 1u);
            const unsigned tg = og / nx;
            if (og + 1u == (tg + 1u) * nx) xb_add(&bar[XB_TOPGEN], 1u);
            else XB_SPIN(xb_ld(&bar[XB_TOPGEN]) == tg, bar);
            __builtin_amdgcn_fence(__ATOMIC_ACQUIRE, "agent");
            xb_add(&bar[XB_XGEN(b.x)], 1u);
            asm volatile("s_waitcnt vmcnt(0)" ::: "memory");
        } else {
            XB_SPIN(xb_ld(&bar[XB_XGEN(b.x)]) == gen, bar);
            __builtin_amdgcn_fence(__ATOMIC_ACQUIRE, "agent");
            asm volatile("s_waitcnt vmcnt(0)" ::: "memory");
        }
    }
    __syncthreads();
}

#ifndef PROBE_DUP
#define PROBE_DUP 0
#endif
#ifndef PHM
#define PHM 0xFFFF
#endif
#define PH(b) if ((PHM >> (b)) & 1)
#define HB ((bf16_t*)(ws + WS_H))
#define P5 ((bf16_t*)(ws + WS_P5))
#define GT ((bf16_t*)(ws + WS_GT))
#define XC ((bf16_t*)(ws + WS_XC))
#define VT ((bf16_t*)(ws + WS_VT))
#define XH ((bf16_t*)(ws + WS_XH))
#define SB ((float*)(ws + WS_SB))
#define TPM ((bf16_t*)(ws + WS_TP))
#define W1M ((bf16_t*)(ws + WS_W1))
#define XSB ((bf16_t*)(ws + WS_XS))
#define AGG ((float*)(ws + WS_AGG))
#define LSG ((float*)(ws + WS_LSG))
#define MIX ((bf16_t*)(ws + WS_GT))
#define PART ((float*)(ws + WS_VT))
#define PART2 ((float*)(ws + WS_XC))
#define HID ((bf16_t*)(ws + WS_GT))
#define FFO ((bf16_t*)(ws + WS_P5))
#define WIN ((bf16_t*)(ws + WS_W + W_IN))
#define WBR ((bf16_t*)(ws + WS_W + W_BR))
#define WOUT ((bf16_t*)(ws + WS_W + W_OUT))
#define WGLU ((bf16_t*)(ws + WS_W + W_GLU))
#define WLRU ((bf16_t*)(ws + WS_W + W_LRU))
#define WF1 ((bf16_t*)(ws + WS_W + W_F1))
#define WF2 ((bf16_t*)(ws + WS_W + W_F2))
#define GASP __attribute__((address_space(1)))
#define PIN(i) ((const float*)(const GASP float*)(P.in[(i) + z]))
#define PHASE_BEGIN unsigned char* ws = opaque_ptr(P.ws); const int z = opaque_zero(); (void)ws; (void)z;
#define GSYNC() xcd_barrier(xbar)
constexpr int LDS_BYTES = 131072 + 1024;
__global__ void __launch_bounds__(512, 2) mega_fwd(Params P) {
    extern __shared__ __attribute__((aligned(16))) unsigned char lds_raw[];
    LAS unsigned char* lds = (LAS unsigned char*)lds_raw;
    cg::grid_group grid = cg::this_grid();
    const int G = gridDim.x, c = blockIdx.x;
    volatile LAS unsigned* bst = (volatile LAS unsigned*)(lds + 131072 + 512);
    if (threadIdx.x < 2) bst[threadIdx.x] = 0u;
    if (c == 0) for (int i = threadIdx.x; i < XCD_BAR_WORDS; i += 512) __hip_atomic_store((unsigned*)(P.ws + WS_BAR) + i, 0u, __ATOMIC_RELAXED, __HIP_MEMORY_SCOPE_AGENT);
    grid.sync();
    const XcdBarrier xbar = xcd_barrier_post((unsigned*)(P.ws + WS_BAR), bst);
    for (int l = 0; l < 2; ++l) {
        PH(0) { PHASE_BEGIN
            phase_norm(P, l == 0 ? 0 : 1, FFO, PIN(I_NORMW) + 3 * D, PIN(I_NORMW) + (size_t)l * 4 * D, HB, XSB, PART, 11); }
        for (int rep_ = 0; rep_ < ((PROBE_DUP & 16) ? 2 : 1); ++rep_) PH(1) { PHASE_BEGIN
            const int tid = opaque_tid(), lane = tid & 63, wave = __builtin_amdgcn_readfirstlane(tid >> 6); const int gw = c * 8 + wave, NGW = (G + z) * 8;
            const float* win = PIN(I_WIN) + (size_t)l * D * 12288; const float* wbr = PIN(I_WBR) + (size_t)l * 3 * 1024 * D; const float* wout = PIN(I_WOUT) + (size_t)l * D * D;
            const float* wglu = PIN(I_S5WG) + (size_t)l * 1024 * 1024;
            const int n_in = 32 * 48, n_br = 16 * 8, n_out = 32 * 8, n_glu = 16 * 4; const int tot = n_in + 3 * n_br + n_out + n_glu;
            { const int tot4 = tot * 4; const int s0 = (int)((unsigned)(gw * tot4) / (unsigned)NGW), s1 = (int)((unsigned)((gw + 1) * tot4) / (unsigned)NGW);
            for (int ss = s0; ss < s1; ++ss) {
                int r = ss >> 2; const int sub = ss & 3;
                if (r < n_in) { transpose_item<0>(win, D, 12288, WIN, r, sub, lane); continue; } r -= n_in;
                if (r < 3 * n_br) { const int i = r / n_br; transpose_item<0>(wbr + (size_t)i * 1024 * D, 1024, D, WBR + (size_t)i * D * 1024, r - i * n_br, sub, lane); continue; } r -= 3 * n_br;
                if (r < n_out) { transpose_item<0>(wout, D, D, WOUT, r, sub, lane); continue; } r -= n_out;
                transpose_item<0>(wglu, 1024, 1024, WGLU, r, sub, lane);
            } }
            const float* wa = PIN(I_LWA) + (size_t)l * 8 * 128 * 128; const float* wx = PIN(I_LWX) + (size_t)l * 8 * 128 * 128;
            for (int e = c * 512 + tid; e < 8 * 256 * 256; e += G * 512) { const int k = e & 255, n = (e >> 8) & 255, hh = e >> 16; float v = 0.f;
                if (k < 128) v = (n < 128) ? wa[((size_t)hh * 128 + k) * 128 + n] : wx[((size_t)hh * 128 + k) * 128 + (n - 128)];
                WLRU[e] = (bf16_t)(cvt_pk_bf16(v, 0.f) & 0xffffu); }
            if (c == 0) for (int e = tid; e < 1024; e += 512) LSG[e] = -8.0f * log1pf(expf(-(PIN(I_LLAM) + (size_t)l * 1024)[e]));
            __syncthreads();
            for (int t = c; t < 256; t += G)
                s5_gen_task(lds, t >> 2, t & 3, PIN(I_S5LR) + l * 4096, PIN(I_S5LI) + l * 4096, PIN(I_S5BR) + (size_t)l * 65536, PIN(I_S5BI) + (size_t)l * 65536,
                             PIN(I_S5CR) + (size_t)l * 65536, PIN(I_S5CI) + (size_t)l * 65536, PIN(I_S5LS) + l * 64, TPM, W1M);
        }
        GSYNC();
        PH(2) { PHASE_BEGIN
          pg8::DenseOrder S{HB, WIN, D, D, MP / 256, 12288 / 256, G, c, D / 64}; pg8::EpiG1 E{P5, XH, GT, PIN(I_BGATE) + (size_t)l * NGATE};
#if PROBE_DUP & 1
          pg8::gemm_phase(lds, D, D, S, E);
#endif
          pg8::gemm_phase(lds, D, D, S, E); }
        GSYNC();
        for (int rep_ = 0; rep_ < ((PROBE_DUP & 64) ? 2 : 1); ++rep_) PH(3) { PHASE_BEGIN
          phase_prep(lds, P5, XC, VT, PIN(I_CONVW) + (size_t)l * 4096, PIN(I_CONVB) + (size_t)l * 1024); }
        GSYNC();
        PH(4) { PHASE_BEGIN
          pg8::GroupOrder S{XC, WLRU, 1024, 256, MP / 256, 1, 8, 0, 256, 128, G, c, 4};
          pg8::EpiLru E{P5, XC, PIN(I_LBA) + (size_t)l * 1024, PIN(I_LBX) + (size_t)l * 1024, LSG};
          pg8::gemm_phase(lds, 1024, 256, S, E); }
        PH(5) { PHASE_BEGIN
          pg8::GroupOrder S{XH, W1M, XLD, 512, 3, 1, 64, XROWS, 128, 0, G, c, 8}; pg8::EpiS5S E{SB};
          pg8::gemm_phase(lds, XLD, 512, S, E); }
        PH(6) { PHASE_BEGIN
          const float lam_init = 0.8f - 0.6f * expf(-0.3f * (float)l);
#if PROBE_DUP & 2
          attn_phase(lds, P5, VT, PIN(I_RELB), PIN(I_DALAM) + (size_t)l * 256, PIN(I_DASUB) + (size_t)l * 128, lam_init, C_V);
#endif
          attn_phase(lds, P5, VT, PIN(I_RELB), PIN(I_DALAM) + (size_t)l * 256, PIN(I_DASUB) + (size_t)l * 128, lam_init, C_Q); }
        GSYNC();
        for (int rep_ = 0; rep_ < ((PROBE_DUP & 128) ? 2 : 1); ++rep_) PH(7) { PHASE_BEGIN
          lru_scan1(P5, XC, AGG);
          s5_carry(XH, SB, PIN(I_S5LR) + l * 4096, PIN(I_S5LI) + l * 4096, PIN(I_S5LS) + l * 64); }
        GSYNC();
        PH(8) { PHASE_BEGIN
          pg8::GroupOrder S{XH, TPM, XLD, XLD, 3, 2, 64, XROWS, 512, 0, G, c, 10}; pg8::EpiS5Y E{P5, XH, PIN(I_S5D) + (size_t)l * 1024};
          pg8::gemm_phase(lds, XLD, XLD, S, E); }
        PH(7) { PHASE_BEGIN
          lru_scan2(P5, XC, AGG); }
        GSYNC();
        PH(9) { PHASE_BEGIN
          pg8::DenseOrder S{P5 + C_V, WGLU, LDP, 1024, MP / 256, 4, G, c, 16}; pg8::EpiGlu E{P5, PIN(I_S5BG) + (size_t)l * 1024};
          pg8::gemm_phase(lds, LDP, 1024, S, E); }
        GSYNC();
        PH(10) { PHASE_BEGIN
          pg8::BranchOrder S{P5, WBR, LDP, 1024, MP / 256, 8, G, c, 16, 4}; pg8::EpiG2 E{GT, (u32x4*)(ws + WS_XH) + (size_t)c * 16 * 512, HB, PART2, 4};
          pg8::gemm_phase(lds, LDP, 1024, S, E); }
        GSYNC();
        PH(10) { PHASE_BEGIN
          pg8::g2_tail_reduce(PART2, 4, HB); }
        GSYNC();
        PH(11) { PHASE_BEGIN
          pg8::SplitOrder S{HB, WOUT, D, D, MP / 256, 8, G, c, D / 64, 4, 8}; pg8::EpiMix E{MIX, D, PART, 4};
          pg8::gemm_phase(lds, D, D, S, E); }
        GSYNC();
        PH(0) { PHASE_BEGIN
          const float* nw = PIN(I_NORMW) + (size_t)l * 4 * D;
          phase_norm(P, l == 0 ? 3 : 1, MIX, nw + D, nw + 2 * D, HB, XSB, PART, 4); }
        for (int rep_ = 0; rep_ < ((PROBE_DUP & 32) ? 2 : 1); ++rep_) PH(1) { PHASE_BEGIN
            const int tid = opaque_tid(), lane = tid & 63, wave = __builtin_amdgcn_readfirstlane(tid >> 6); const int gw = c * 8 + wave, NGW = (G + z) * 8;
            const float* wf1 = PIN(I_WF1) + (size_t)l * D * 2 * DFF; const float* wf2 = PIN(I_WF2) + (size_t)l * DFF * D;
            const int n1 = 32 * 44, n2 = 88 * 8;
            { const int tot4 = (n1 + n2) * 4; const int s0 = (int)((unsigned)(gw * tot4) / (unsigned)NGW), s1 = (int)((unsigned)((gw + 1) * tot4) / (unsigned)NGW);
            for (int ss = s0; ss < s1; ++ss) {
                const int it = ss >> 2, sub = ss & 3;
                if (it < n1) transpose_item<1>(wf1, D, 2 * DFF, WF1, it, sub, lane);
                else transpose_item<0>(wf2, DFF, D, WF2, it - n1, sub, lane);
            } }
        }
        GSYNC();
        PH(12) { PHASE_BEGIN
          pg8::DenseOrder S{HB, WF1, D, D, MP / 256, 44, G, c, D / 64}; pg8::EpiSwiglu E{HID};
#if PROBE_DUP & 256
          pg8::gemm_phase(lds, D, D, S, E);
#endif
          pg8::gemm_phase(lds, D, D, S, E); }
        GSYNC();
        PH(11) { PHASE_BEGIN
          pg8::SplitOrder S{HID, WF2, DFF, DFF, MP / 256, 8, G, c, DFF / 64, 11, 8}; pg8::EpiMix E{FFO, D, PART, 11};
#if PROBE_DUP & 8
          pg8::gemm_phase(lds, DFF, DFF, S, E);
#endif
          pg8::gemm_phase(lds, DFF, DFF, S, E); }
        GSYNC();
    }
    PH(0) { PHASE_BEGIN
      phase_norm(P, 2, FFO, PIN(I_NORMW) + (size_t)(4 + 3) * D, nullptr, HB, XSB, PART, 11); }
}

extern "C" void kernel_launch(void* const* d_in, const int* in_sizes, int n_in, void* d_out, int out_size, void* d_ws, size_t ws_size, hipStream_t stream) {
    static int grid_blocks = 0;
    if (!grid_blocks) {
        int dev = 0, cus = 0, per_cu = 0;
        hipGetDevice(&dev);
        hipDeviceGetAttribute(&cus, hipDeviceAttributeMultiprocessorCount, dev);
        hipFuncSetAttribute((const void*)mega_fwd, hipFuncAttributeMaxDynamicSharedMemorySize, LDS_BYTES);
        hipOccupancyMaxActiveBlocksPerMultiprocessor(&per_cu, (const void*)mega_fwd, 512, LDS_BYTES);
        if (per_cu < 1) per_cu = 1;
        grid_blocks = cus * per_cu;
        if (ws_size < WS_END) fprintf(stderr, "kernel_launch: workspace too small: %zu < %zu\n", ws_size, (size_t)WS_END);
    }
    Params p{};
    for (int i = 0; i < 29; ++i) p.in[i] = (const float*)d_in[i];
    p.out = (float*)d_out; p.ws = (unsigned char*)d_ws;
    void* args[] = {&p};
    hipError_t e = hipLaunchCooperativeKernel((const void*)mega_fwd, dim3(grid_blocks), dim3(512), args, LDS_BYTES, stream);
    if (e != hipSuccess) fprintf(stderr, "cooperative launch failed: %s (grid %d)\n", hipGetErrorString(e), grid_blocks);
}
```

```cpp
#include <hip/hip_runtime.h>
#include <hip/hip_cooperative_groups.h>
#include <cstdio>
#include <cstdint>
namespace cg = cooperative_groups;

#define LAS __attribute__((address_space(3)))
typedef unsigned short bf16_t;
typedef short bf16x8 __attribute__((ext_vector_type(8)));
typedef short bf16x4 __attribute__((ext_vector_type(4)));
typedef float f32x4 __attribute__((ext_vector_type(4)));
typedef float f32x2 __attribute__((ext_vector_type(2)));
typedef unsigned u32x4 __attribute__((ext_vector_type(4)));
typedef unsigned u32x2 __attribute__((ext_vector_type(2)));

constexpr int NB = 4, SEQ = 4096, PADT = 48, TP = 4160, MP = NB * TP;
constexpr int D = 2048, DFF = 5632, LDP = 5120, NGATE = 6144;
constexpr int C_AG = 0, C_AX = 1024, C_Q = 2048, C_K = 3072, C_V = 4096;
constexpr int NCH32 = 130, XROWS = 768, XLD = 640;
constexpr int NCH64 = 65;
constexpr float LOG2E = 1.4426950408889634f;

constexpr size_t MiB = 1u << 20;
constexpr size_t WS_W = 0;
constexpr size_t W_IN = 0, W_BR = 48 * MiB, W_OUT = 60 * MiB, W_GLU = 68 * MiB, W_LRU = 70 * MiB;
constexpr size_t W_F1 = 0, W_F2 = 44 * MiB;
constexpr size_t WS_H = 72 * MiB;
constexpr size_t WS_P5 = 137 * MiB;
constexpr size_t WS_GT = 300 * MiB;
constexpr size_t WS_XC = 495 * MiB;
constexpr size_t WS_VT = 528 * MiB;
constexpr size_t WS_XH = 561 * MiB;
constexpr size_t WS_SB = 621 * MiB;
constexpr size_t WS_TP = 645 * MiB;
constexpr size_t WS_W1 = 685 * MiB;
constexpr size_t WS_AGG = 694 * MiB;
constexpr size_t WS_LSG = 697 * MiB;
constexpr size_t WS_BAR = 697 * MiB + 65536;
constexpr size_t WS_XS = 698 * MiB;
constexpr size_t WS_END = 763 * MiB;

struct Params { const float* in[29]; float* out; unsigned char* ws; };
enum { I_X = 0, I_META, I_RELB, I_NORMW, I_WIN, I_CONVW, I_CONVB, I_LWA, I_LBA, I_LWX, I_LBX, I_LLAM, I_DALAM, I_DASUB, I_S5LR, I_S5LI,
       I_S5BR, I_S5BI, I_S5CR, I_S5CI, I_S5D, I_S5LS, I_S5WG, I_S5BG, I_BGATE, I_WBR, I_WOUT, I_WF1, I_WF2 };

__device__ __forceinline__ int opaque_zero() { int z = 0; asm volatile("" : "+v"(z)); return __builtin_amdgcn_readfirstlane(z); }
__device__ __forceinline__ unsigned char* opaque_ptr(unsigned char* p) { const unsigned long long u = (unsigned long long)p; int lo = (int)(unsigned)u, hi = (int)(unsigned)(u >> 32);
    asm volatile("" : "+v"(lo), "+v"(hi)); lo = __builtin_amdgcn_readfirstlane(lo); hi = __builtin_amdgcn_readfirstlane(hi);
    return (unsigned char*)(__attribute__((address_space(1))) unsigned char*)(((unsigned long long)(unsigned)hi << 32) | (unsigned)lo); }
__device__ __forceinline__ int opaque_tid() { int t = threadIdx.x; asm volatile("" : "+v"(t)); return t; }
__device__ __forceinline__ unsigned cvt_pk_bf16(float lo, float hi) { unsigned r; asm volatile("v_cvt_pk_bf16_f32 %0, %1, %2" : "=v"(r) : "v"(lo), "v"(hi)); return r; }
__device__ __forceinline__ float bf_lo(unsigned w) { return __uint_as_float(w << 16); }
__device__ __forceinline__ float bf_hi(unsigned w) { return __uint_as_float(w & 0xffff0000u); }
__device__ __forceinline__ float bf2f(bf16_t v) { return __uint_as_float(((unsigned)v) << 16); }
__device__ __forceinline__ float sigmoidf_(float x) { return __builtin_amdgcn_rcpf(1.0f + __builtin_amdgcn_exp2f(-1.4426950408889634f * x)); }
__device__ __forceinline__ float gelu_tanh(float x) { const float u = 1.5957691216057308f * (x + 0.044715f * x * x * x); return x * sigmoidf_(u); }
__device__ __forceinline__ float wave_sum(float v) {
    v += __builtin_bit_cast(float, __builtin_amdgcn_update_dpp(0, __builtin_bit_cast(int, v), 0xB1, 0xF, 0xF, true));
    v += __builtin_bit_cast(float, __builtin_amdgcn_update_dpp(0, __builtin_bit_cast(int, v), 0x4E, 0xF, 0xF, true));
    v += __builtin_bit_cast(float, __builtin_amdgcn_update_dpp(0, __builtin_bit_cast(int, v), 0x124, 0xF, 0xF, true));
    v += __builtin_bit_cast(float, __builtin_amdgcn_update_dpp(0, __builtin_bit_cast(int, v), 0x128, 0xF, 0xF, true));
    unsigned a = __float_as_uint(v); auto r = __builtin_amdgcn_permlane16_swap(a, a, false, false); v = __uint_as_float(r[0]) + __uint_as_float(r[1]);
    a = __float_as_uint(v); auto r2 = __builtin_amdgcn_permlane32_swap(a, a, false, false); return __uint_as_float(r2[0]) + __uint_as_float(r2[1]);
}
__device__ __forceinline__ float* xs_row(float* out, float* metab, int m) {
    const int b = m / TP, tp = m - b * TP;
    if (tp < PADT) return nullptr;
    if (tp < 64) return metab + (size_t)(b * 16 + tp - PADT) * D;
    return out + ((size_t)b * SEQ + (tp - 64)) * D;
}

namespace pg8 {
constexpr int BM = 256, BK = 64, HALF = 128, HTB = HALF * BK * 2, STAGE_BYTES = 8 * HTB, NXCD = 8, WGM = 8;
__device__ __forceinline__ int lds_byte(int r, int c) { const int st = (r >> 4) * 2 + (c >> 5), rr = r & 15, cc = c & 31, ob = rr * 64 + cc * 2; return st * 1024 + (ob ^ (((ob >> 9) & 1) << 5)); }
__device__ __forceinline__ void stage_rc(int b, int& R, int& C) { const int st = b / 1024, sb = b % 1024, swz = sb ^ (((sb >> 9) & 1) << 5); R = (st >> 1) * 16 + swz / 64; C = (st & 1) * 32 + (swz % 64) / 2; }
__device__ __forceinline__ int perm32(int rho) { const int n = rho >> 4, i = rho & 15; return 8 * (i >> 2) + 4 * n + (i & 3); }

struct Unit { const char* A; const char* B; int pm, pn, aux, nt; };

__device__ __forceinline__ void dense_tile(int L, int nM, int nN, int& pm, int& pn) {
    const int nwg = nM * nN; int wgid = L;
    { const int q = nwg / NXCD, r = nwg % NXCD, xcd = wgid % NXCD, off = wgid / NXCD; wgid = (xcd < r ? xcd * (q + 1) : r * (q + 1) + (xcd - r) * q) + off; }
    const int nig = WGM * nN, gid = wgid / nig, fm = gid * WGM, gsz = (nM - fm) < WGM ? (nM - fm) : WGM;
    pm = fm + ((wgid % nig) % gsz); pn = (wgid % nig) / gsz;
}
struct DenseOrder {
    const bf16_t* A; const bf16_t* Bt; int lda, ldb, nM, nN, G, c, ntk;
    __device__ __forceinline__ bool next(int i, Unit& u) const {
        const int L = i * G + c; if (L >= nM * nN) return false;
        int pm, pn; dense_tile(L, nM, nN, pm, pn);
        u.pm = pm; u.pn = pn; u.aux = 0; u.nt = ntk;
        u.A = (const char*)(A + (size_t)pm * 256 * lda); u.B = (const char*)(Bt + (size_t)pn * 256 * ldb); return true;
    }
};
struct SplitOrder {
    const bf16_t* A; const bf16_t* Bt; int lda, ldb, nM, nN, G, c, ntk, pieces, nt_piece;
    __device__ __forceinline__ bool next(int i, Unit& u) const {
        const int nfull = (nM - 1) * nN; const int L = i * G + c; int pm, pn, pc = 0, full = 1;
        if (L < nfull) dense_tile(L, nM - 1, nN, pm, pn);
        else { const int s_ = L - nfull; if (s_ >= nN * pieces) return false; pn = s_ / pieces; pc = s_ - pn * pieces; pm = nM - 1; full = 0; }
        u.pm = pm; u.pn = pn; u.aux = full ? 0 : 1 + pc; u.nt = full ? ntk : nt_piece;
        u.A = (const char*)(A + (size_t)pm * 256 * lda + (size_t)pc * nt_piece * 64); u.B = (const char*)(Bt + (size_t)pn * 256 * ldb + (size_t)pc * nt_piece * 64); return true;
    }
};
struct BranchOrder {
    const bf16_t* A0; const bf16_t* Bt; int lda, ldb, nM, nN, G, c, ntk, pieces;
    __device__ __forceinline__ bool next(int i, Unit& u) const {
        const int nfull = (nM - 1) * nN, rounds = nfull / G;
        int pm, pn, br, pc = 0;
        if (i < 3 * rounds) { const int r = i / 3; br = i - 3 * r; dense_tile(r * G + c, nM - 1, nN, pm, pn); u.nt = ntk; u.aux = br; }
        else { const int s_ = (i - 3 * rounds) * G + c; if (s_ >= nN * 3 * pieces) return false;
            pn = s_ / (3 * pieces); const int rem = s_ - pn * 3 * pieces; br = rem / pieces; pc = rem - br * pieces; pm = nM - 1; u.nt = ntk / pieces; u.aux = br | ((1 + pc) << 2); }
        u.pm = pm; u.pn = pn;
        const int acol = br == 0 ? C_AG : (br == 1 ? C_Q : C_K);
        u.A = (const char*)(A0 + (size_t)pm * 256 * lda + acol + (size_t)pc * (ntk / pieces) * 64);
        u.B = (const char*)(Bt + (size_t)br * 2048 * 1024 + (size_t)pn * 256 * ldb + (size_t)pc * (ntk / pieces) * 64); return true;
    }
};
struct GroupOrder {
    const bf16_t* A; const bf16_t* Bt; int lda, ldb, nM, nN, ngroups, a_gstride_rows, b_gstride_rows, a_gcol, G, c, ntk;
    __device__ __forceinline__ bool next(int i, Unit& u) const {
        const int L = i * G + c; const int per = nM * nN; if (L >= per * ngroups) return false;
        const int g = L / per, r = L - g * per; const int pm = r / nN, pn = r - pm * nN;
        u.pm = pm; u.pn = pn; u.aux = g; u.nt = ntk;
        u.A = (const char*)(A + ((size_t)g * a_gstride_rows + (size_t)pm * 256) * lda + (size_t)g * a_gcol);
        u.B = (const char*)(Bt + ((size_t)g * b_gstride_rows + (size_t)pn * 256) * ldb); return true;
    }
};

template <class Epi, class Sched>
__device__ __forceinline__ void gemm_phase(LAS unsigned char* lds, const int lda, const int ldb, const Sched& S, const Epi& E) {
    int tid_ = threadIdx.x; asm volatile("" : "+v"(tid_));
    const int tid = tid_, wid = __builtin_amdgcn_readfirstlane(tid >> 6), lane = tid & 63, wr = wid >> 2, wc = wid & 3, fr = lane & 15, fq = lane >> 4;
    unsigned voffA[2], voffB[2];
#pragma unroll
    for (int i = 0; i < 2; ++i) { int R, C; stage_rc(tid * 16 + i * 8192, R, C); const int Rb = Epi::PERM ? ((R & ~31) + perm32(R & 31)) : R;
        voffA[i] = (unsigned)(R * lda + C) * 2u; voffB[i] = (unsigned)(Rb * ldb + C) * 2u; }
    const size_t kstep = (size_t)(BK * 2);
    const size_t hstepA = (size_t)HALF * lda * 2, hstepB = (size_t)HALF * ldb * 2;
    const unsigned ldsw = (unsigned)wid * 1024u;
    const int aoff = lds_byte(wr * 64 + fr, fq * 8), boff = lds_byte(wc * 32 + fr, fq * 8);
#define PG8_SA(b, h) (((b) * 2 + (h)) * HTB)
#define PG8_SB(b, h) ((4 + (b) * 2 + (h)) * HTB)
#define PG8_STAGE(bufoff, gbase, voff) do { _Pragma("unroll") for (int _i = 0; _i < 2; ++_i) \
        __builtin_amdgcn_global_load_lds((const unsigned*)((const char*)(gbase) + (voff)[_i]), (LAS unsigned*)(lds + (bufoff) + ldsw + _i * 8192), 16, 0, 0); } while (0)
#define PG8_LDA(dst, b, h) do { _Pragma("unroll") for (int m = 0; m < 4; ++m) _Pragma("unroll") for (int k = 0; k < 2; ++k) dst[m][k] = *(const LAS bf16x8*)(lds + PG8_SA(b, h) + aoff + m * 2048 + k * 1024); } while (0)
#define PG8_LDB(dst, b, h) do { _Pragma("unroll") for (int n = 0; n < 2; ++n) _Pragma("unroll") for (int k = 0; k < 2; ++k) dst[n][k] = *(const LAS bf16x8*)(lds + PG8_SB(b, h) + boff + n * 2048 + k * 1024); } while (0)
#define PG8_MMA(ai, bj, At, Bt) do { __builtin_amdgcn_s_setprio(1); _Pragma("unroll") for (int m = 0; m < 4; ++m) _Pragma("unroll") for (int n = 0; n < 2; ++n) _Pragma("unroll") for (int k = 0; k < 2; ++k) \
        acc[ai][bj][m][n] = __builtin_amdgcn_mfma_f32_16x16x32_bf16(Bt[n][k], At[m][k], acc[ai][bj][m][n], 0, 0, 0); __builtin_amdgcn_s_setprio(0); } while (0)
#define PG8_WAIT_V(n) asm volatile("s_waitcnt vmcnt(" #n ")" ::: "memory")
#define PG8_WAIT_L(n) asm volatile("s_waitcnt lgkmcnt(" #n ")" ::: "memory")
#define PG8_BAR __builtin_amdgcn_s_barrier()
#define PG8_SCHED __builtin_amdgcn_sched_barrier(0)
    Unit cur, nxt; int ui = 0;
    if (!S.next(0, cur)) return;
    f32x4 acc[2][2][4][2];
#pragma unroll
    for (int a = 0; a < 2; ++a)
#pragma unroll
        for (int b = 0; b < 2; ++b)
#pragma unroll
            for (int m = 0; m < 4; ++m)
#pragma unroll
                for (int n = 0; n < 2; ++n) acc[a][b][m][n] = (f32x4){0.f, 0.f, 0.f, 0.f};
    bf16x8 At[4][2], B0[2][2], B1[2][2];
    const char* cA = cur.A; const char* cB = cur.B; asm volatile("" : "+s"(cA), "+s"(cB));
    PG8_STAGE(PG8_SB(0, 0), cB, voffB); PG8_STAGE(PG8_SB(0, 1), cB + hstepB, voffB); PG8_STAGE(PG8_SA(0, 0), cA, voffA); PG8_STAGE(PG8_SA(0, 1), cA + hstepA, voffA);
    if (wr == 1) PG8_BAR;
    PG8_WAIT_V(2); PG8_BAR;
    PG8_STAGE(PG8_SB(1, 0), cB + kstep, voffB); PG8_STAGE(PG8_SA(1, 0), cA + kstep, voffA); PG8_STAGE(PG8_SB(1, 1), cB + hstepB + kstep, voffB);
    PG8_WAIT_V(6); PG8_BAR;
    for (;;) {
        const bool has_next = S.next(ui + 1, nxt);
        const char* nA = has_next ? nxt.A : cA; const char* nB = has_next ? nxt.B : cB;
        const int nt = cur.nt;
#pragma unroll 1
        for (int t = 0; t < nt; t += 2) {
            const bool last = (t == nt - 2);
            const char* a1 = cA + (size_t)(t + 1) * kstep;
            const char* a2 = last ? nA : cA + (size_t)(t + 2) * kstep; const char* b2 = last ? nB : cB + (size_t)(t + 2) * kstep;
            const char* a3 = a2 + kstep; const char* b3 = b2 + kstep;
            PG8_LDB(B0, 0, 0); PG8_LDB(B1, 0, 1); PG8_SCHED; PG8_LDA(At, 0, 0); PG8_STAGE(PG8_SA(1, 1), a1 + hstepA, voffA);
            PG8_WAIT_V(8); PG8_WAIT_L(0); PG8_BAR; PG8_MMA(0, 0, At, B0); PG8_MMA(0, 1, At, B1); PG8_BAR; PG8_SCHED;
            PG8_LDA(At, 0, 1); PG8_STAGE(PG8_SB(0, 0), b2, voffB); PG8_STAGE(PG8_SB(0, 1), b2 + hstepB, voffB); PG8_STAGE(PG8_SA(0, 0), a2, voffA);
            PG8_WAIT_V(8); PG8_WAIT_L(0); PG8_BAR; PG8_MMA(1, 0, At, B0); PG8_MMA(1, 1, At, B1); PG8_BAR; PG8_SCHED;
            PG8_LDB(B0, 1, 0); PG8_LDB(B1, 1, 1); PG8_SCHED; PG8_LDA(At, 1, 0); PG8_STAGE(PG8_SA(0, 1), a2 + hstepA, voffA);
            PG8_WAIT_V(8); PG8_WAIT_L(0); PG8_BAR; PG8_MMA(0, 0, At, B0); PG8_MMA(0, 1, At, B1); PG8_BAR; PG8_SCHED;
            PG8_LDA(At, 1, 1); PG8_STAGE(PG8_SB(1, 0), b3, voffB); PG8_STAGE(PG8_SB(1, 1), b3 + hstepB, voffB); PG8_STAGE(PG8_SA(1, 0), a3, voffA);
            PG8_WAIT_V(8); PG8_WAIT_L(0); PG8_BAR; PG8_MMA(1, 0, At, B0); PG8_MMA(1, 1, At, B1); PG8_BAR; PG8_SCHED;
        }
        if (wr == 0) PG8_BAR;
        { const int t2 = opaque_tid(); const int w2 = __builtin_amdgcn_readfirstlane(t2 >> 6); E(acc, cur, w2 >> 2, w2 & 3, t2 & 15, (t2 & 63) >> 4); }
        if (!has_next) break;
#pragma unroll
        for (int a = 0; a < 2; ++a)
#pragma unroll
            for (int b = 0; b < 2; ++b)
#pragma unroll
                for (int m = 0; m < 4; ++m)
#pragma unroll
                    for (int n = 0; n < 2; ++n) acc[a][b][m][n] = (f32x4){0.f, 0.f, 0.f, 0.f};
        cur = nxt; cA = nA; cB = nB; ++ui;
        if (wr == 1) PG8_BAR;
    }
    PG8_WAIT_V(0);
    PG8_BAR;
#undef PG8_SA
#undef PG8_SB
#undef PG8_STAGE
#undef PG8_LDA
#undef PG8_LDB
#undef PG8_MMA
#undef PG8_WAIT_V
#undef PG8_WAIT_L
#undef PG8_BAR
#undef PG8_SCHED
}

typedef f32x4 Acc[2][2][4][2];

struct EpiG1 {
    static constexpr bool PERM = true;
    bf16_t* p5; bf16_t* xh; bf16_t* gates; const float* bgate;
    __device__ __forceinline__ void operator()(const Acc& acc, const Unit& u, int wr, int wc, int fr, int fq) const {
        const int row0 = u.pm * 256 + wr * 64 + fr; const int pn = u.pn;
        f32x4 gb[2][2];
#pragma unroll
        for (int bj = 0; bj < 2; ++bj) { const int cg_ = (pn >= 24 ? (pn - 24) * 256 : 0) + bj * 128 + wc * 32 + 8 * fq;
            gb[bj][0] = *(const f32x4*)(bgate + cg_); gb[bj][1] = *(const f32x4*)(bgate + cg_ + 4); }
#pragma unroll
        for (int ai = 0; ai < 2; ++ai)
#pragma unroll
            for (int m = 0; m < 4; ++m) {
                const int row = row0 + ai * 128 + m * 16;
#pragma unroll
                for (int bj = 0; bj < 2; ++bj) {
                    const int colt = bj * 128 + wc * 32 + 8 * fq;
                    f32x4 v0 = acc[ai][bj][m][0], v1 = acc[ai][bj][m][1];
                    bf16_t* dst;
                    if (pn < 20) dst = p5 + (size_t)row * LDP + pn * 256 + colt;
                    else if (pn < 24) {
                        const int cu = (pn - 20) * 256 + colt, g = cu >> 4, c0 = cu & 15;
                        const int b = row / TP, tp = row - b * TP, chunk = tp >> 5, jj = tp & 31;
                        dst = xh + ((size_t)g * XROWS + b * NCH32 + chunk) * XLD + jj * 16 + c0;
                    } else {
                        const int cg_ = (pn - 24) * 256 + colt;
                        unsigned q0 = 0u, q1 = 0u;
#pragma unroll
                        for (int j = 0; j < 4; ++j) { q0 |= (unsigned)(sigmoidf_(v0[j] + gb[bj][0][j]) * 255.0f + 0.5f) << (8 * j); q1 |= (unsigned)(sigmoidf_(v1[j] + gb[bj][1][j]) * 255.0f + 0.5f) << (8 * j); }
                        *(u32x2*)((unsigned char*)gates + (size_t)row * NGATE + cg_) = (u32x2){q0, q1};
                        continue;
                    }
                    u32x4 w; w.x = cvt_pk_bf16(v0[0], v0[1]); w.y = cvt_pk_bf16(v0[2], v0[3]); w.z = cvt_pk_bf16(v1[0], v1[1]); w.w = cvt_pk_bf16(v1[2], v1[3]);
                    *(u32x4*)dst = w;
                }
            }
    }
};
struct EpiLru {
    static constexpr bool PERM = true;
    bf16_t* p5; bf16_t* xc; const float* ba; const float* bx; const float* lsgp;
    __device__ __forceinline__ void operator()(const Acc& acc, const Unit& u, int wr, int wc, int fr, int fq) const {
        const int row0 = u.pm * 256 + wr * 64 + fr; int chb = u.aux * 128 + wc * 32 + 8 * fq; asm volatile("" : "+v"(chb));
#pragma unroll
        for (int n = 0; n < 2; ++n) {
            const int ch0 = chb + 4 * n;
            const f32x4 lsg = *(const f32x4*)(lsgp + ch0), bav = *(const f32x4*)(ba + ch0), bxv = *(const f32x4*)(bx + ch0);
            u32x2 xw[2][4];
#pragma unroll
            for (int ai = 0; ai < 2; ++ai)
#pragma unroll
                for (int m = 0; m < 4; ++m) xw[ai][m] = *(const u32x2*)(xc + (size_t)(row0 + ai * 128 + m * 16) * 1024 + ch0);
#pragma unroll
            for (int ai = 0; ai < 2; ++ai)
#pragma unroll
                for (int m = 0; m < 4; ++m) {
                    const int row = row0 + ai * 128 + m * 16; const int tp = row % TP;
                    const float xv[4] = {bf_lo(xw[ai][m].x), bf_hi(xw[ai][m].x), bf_lo(xw[ai][m].y), bf_hi(xw[ai][m].y)};
                    float la[4], bb[4];
#pragma unroll
                    for (int j = 0; j < 4; ++j) {
                        const float rp = acc[ai][0][m][n][j], ip = acc[ai][1][m][n][j];
                        const float l_ = lsg[j] * sigmoidf_(rp + bav[j]);
                        la[j] = l_;
                        const float t2 = 1.0f - __expf(2.0f * l_);
                        bb[j] = (tp < PADT) ? 0.0f : sqrtf(fmaxf(t2, 0.0f)) * sigmoidf_(ip + bxv[j]) * xv[j];
                    }
                    *(u32x2*)(p5 + (size_t)row * LDP + C_AX + ch0) = (u32x2){cvt_pk_bf16(la[0], la[1]), cvt_pk_bf16(la[2], la[3])};
                    *(u32x2*)(xc + (size_t)row * 1024 + ch0) = (u32x2){cvt_pk_bf16(bb[0], bb[1]), cvt_pk_bf16(bb[2], bb[3])};
                }
            asm volatile("" ::: "memory");
        }
    }
};
struct EpiS5S {
    static constexpr bool PERM = false;
    float* sb;
    __device__ __forceinline__ void operator()(const Acc& acc, const Unit& u, int wr, int wc, int fr, int fq) const {
        const int row0 = u.aux * XROWS + u.pm * 256 + wr * 64 + fr; const int col0 = wc * 32 + 4 * fq;
#pragma unroll
        for (int ai = 0; ai < 2; ++ai)
#pragma unroll
            for (int m = 0; m < 4; ++m) { float* rowp = sb + (size_t)(row0 + ai * 128 + m * 16) * 128 + col0;
#pragma unroll
                for (int n = 0; n < 2; ++n) *(f32x4*)(rowp + n * 16) = acc[ai][0][m][n]; }
    }
};
struct EpiS5Y {
    static constexpr bool PERM = true;
    bf16_t* p5; const bf16_t* xh; const float* dsk;
    __device__ __forceinline__ void operator()(const Acc& acc, const Unit& u, int wr, int wc, int fr, int fq) const {
        const int g = u.aux; const int rr0 = u.pm * 256 + wr * 64 + fr;
        f32x4 dv[2][2];
#pragma unroll
        for (int bj = 0; bj < 2; ++bj) { const int n0 = u.pn * 256 + bj * 128 + wc * 32 + 8 * fq; const int ch = g * 16 + (n0 & 15);
            dv[bj][0] = *(const f32x4*)(dsk + ch); dv[bj][1] = *(const f32x4*)(dsk + ch + 4); }
#pragma unroll
        for (int ai = 0; ai < 2; ++ai) {
            u32x4 uw[4][2];
#pragma unroll
            for (int m = 0; m < 4; ++m)
#pragma unroll
                for (int bj = 0; bj < 2; ++bj) uw[m][bj] = *(const u32x4*)(xh + ((size_t)g * XROWS + rr0 + ai * 128 + m * 16) * XLD + u.pn * 256 + bj * 128 + wc * 32 + 8 * fq);
#pragma unroll
            for (int m = 0; m < 4; ++m) {
                const int rr = rr0 + ai * 128 + m * 16;
                if (rr < NB * NCH32) {
                    const int b = rr / NCH32, chunk = rr - b * NCH32;
#pragma unroll
                    for (int bj = 0; bj < 2; ++bj) {
                        const int n0 = u.pn * 256 + bj * 128 + wc * 32 + 8 * fq; const int i = n0 >> 4, co0 = n0 & 15;
                        const u32x4 w_ = uw[m][bj];
                        const float uv[8] = {bf_lo(w_.x), bf_hi(w_.x), bf_lo(w_.y), bf_hi(w_.y), bf_lo(w_.z), bf_hi(w_.z), bf_lo(w_.w), bf_hi(w_.w)};
                        const int ch = g * 16 + co0; float y[8];
#pragma unroll
                        for (int j = 0; j < 8; ++j) y[j] = gelu_tanh(acc[ai][bj][m][j >> 2][j & 3] + dv[bj][j >> 2][j & 3] * uv[j]);
                        u32x4 w; w.x = cvt_pk_bf16(y[0], y[1]); w.y = cvt_pk_bf16(y[2], y[3]); w.z = cvt_pk_bf16(y[4], y[5]); w.w = cvt_pk_bf16(y[6], y[7]);
                        *(u32x4*)(p5 + ((size_t)b * TP + chunk * 32 + i) * LDP + C_V + ch) = w;
                    }
                }
            }
            asm volatile("" ::: "memory");
        }
    }
};
struct EpiGlu {
    static constexpr bool PERM = true;
    bf16_t* p5; const float* bglu;
    __device__ __forceinline__ void operator()(const Acc& acc, const Unit& u, int wr, int wc, int fr, int fq) const {
        const int row0 = u.pm * 256 + wr * 64 + fr;
#pragma unroll
        for (int bj = 0; bj < 2; ++bj) {
            const int col = u.pn * 256 + bj * 128 + wc * 32 + 8 * fq;
            const f32x4 b0 = *(const f32x4*)(bglu + col), b1 = *(const f32x4*)(bglu + col + 4);
            u32x4 yw[2][4];
#pragma unroll
            for (int ai = 0; ai < 2; ++ai)
#pragma unroll
                for (int m = 0; m < 4; ++m) yw[ai][m] = *(const u32x4*)(p5 + (size_t)(row0 + ai * 128 + m * 16) * LDP + C_V + col);
#pragma unroll
            for (int ai = 0; ai < 2; ++ai)
#pragma unroll
                for (int m = 0; m < 4; ++m) {
                    const int row = row0 + ai * 128 + m * 16; const u32x4 w_ = yw[ai][m];
                    const float yv[8] = {bf_lo(w_.x), bf_hi(w_.x), bf_lo(w_.y), bf_hi(w_.y), bf_lo(w_.z), bf_hi(w_.z), bf_lo(w_.w), bf_hi(w_.w)};
                    float o[8];
#pragma unroll
                    for (int j = 0; j < 8; ++j) o[j] = yv[j] * sigmoidf_(acc[ai][bj][m][j >> 2][j & 3] + (j < 4 ? b0[j & 3] : b1[j & 3]));
                    u32x4 w; w.x = cvt_pk_bf16(o[0], o[1]); w.y = cvt_pk_bf16(o[2], o[3]); w.z = cvt_pk_bf16(o[4], o[5]); w.w = cvt_pk_bf16(o[6], o[7]);
                    *(u32x4*)(p5 + (size_t)row * LDP + C_K + col) = w;
                }
            asm volatile("" ::: "memory");
        }
    }
};
struct EpiG2 {
    static constexpr bool PERM = true;
    const bf16_t* gates; u32x4* scr; bf16_t* merged; float* part; int pieces;
    __device__ __forceinline__ void operator()(const Acc& acc, const Unit& u, int wr, int wc, int fr, int fq) const {
        const int row0 = u.pm * 256 + wr * 64 + fr; const int br = u.aux & 3, pcs = u.aux >> 2;
        unsigned soff = (unsigned)opaque_tid();
        float* pbase = part + (size_t)((u.pn * 3 + br) * pieces + (pcs - 1)) * 65536;
#pragma unroll
        for (int ai = 0; ai < 2; ++ai)
#pragma unroll
            for (int mh = 0; mh < 2; ++mh) {
                u32x2 gw[2][2]; u32x4 ps[2][2];
#pragma unroll
                for (int mm = 0; mm < 2; ++mm)
#pragma unroll
                    for (int bj = 0; bj < 2; ++bj) {
                        const int row = row0 + ai * 128 + (2 * mh + mm) * 16, col = u.pn * 256 + bj * 128 + wc * 32 + 8 * fq;
                        gw[mm][bj] = *(const u32x2*)((const unsigned char*)gates + (size_t)row * NGATE + br * 2048 + col);
                        if (br > 0 && pcs == 0) ps[mm][bj] = scr[soff + (mm * 2 + bj) * 512];
                    }
#pragma unroll
                for (int mm = 0; mm < 2; ++mm)
#pragma unroll
                    for (int bj = 0; bj < 2; ++bj) {
                        const int m = 2 * mh + mm; const int row = row0 + ai * 128 + m * 16; const int colt = bj * 128 + wc * 32 + 8 * fq, col = u.pn * 256 + colt;
                        const u32x2 g_ = gw[mm][bj]; const float k255 = 1.0f / 255.0f;
                        f32x4 v0 = acc[ai][bj][m][0], v1 = acc[ai][bj][m][1];
#pragma unroll
                        for (int j = 0; j < 4; ++j) { v0[j] *= (float)((g_.x >> (8 * j)) & 0xffu) * k255; v1[j] *= (float)((g_.y >> (8 * j)) & 0xffu) * k255; }
                        if (pcs) { float* d = pbase + (size_t)(wr * 64 + fr + ai * 128 + m * 16) * 256 + colt; *(f32x4*)d = v0; *(f32x4*)(d + 4) = v1; }
                        else {
                            if (br > 0) { const u32x4 p_ = ps[mm][bj];
                                v0[0] += bf_lo(p_.x); v0[1] += bf_hi(p_.x); v0[2] += bf_lo(p_.y); v0[3] += bf_hi(p_.y);
                                v1[0] += bf_lo(p_.z); v1[1] += bf_hi(p_.z); v1[2] += bf_lo(p_.w); v1[3] += bf_hi(p_.w); }
                            u32x4 w; w.x = cvt_pk_bf16(v0[0], v0[1]); w.y = cvt_pk_bf16(v0[2], v0[3]); w.z = cvt_pk_bf16(v1[0], v1[1]); w.w = cvt_pk_bf16(v1[2], v1[3]);
                            if (br < 2) scr[soff + (mm * 2 + bj) * 512] = w;
                            else *(u32x4*)(merged + (size_t)row * D + col) = w;
                        }
                    }
                soff += 2048u; asm volatile("" : "+v"(soff) :: "memory");
            }
    }
};
__device__ __forceinline__ void g2_tail_reduce(const float* part, int pieces, bf16_t* merged) {
    const int tid = opaque_tid(); const int pn = (4 * tid) >> 8, cc = (4 * tid) & 255;
    for (int R = blockIdx.x; R < 256; R += gridDim.x) {
        f32x4 a = (f32x4){0.f, 0.f, 0.f, 0.f};
        f32x4 pv[12];
#pragma unroll
        for (int k = 0; k < 12; ++k) pv[k] = (k < 3 * pieces) ? *(const f32x4*)(part + (size_t)(pn * 3 * pieces + k) * 65536 + (size_t)R * 256 + cc) : (f32x4){0.f, 0.f, 0.f, 0.f};
#pragma unroll
        for (int k = 0; k < 12; ++k) a += pv[k];
        *(u32x2*)(merged + (size_t)(MP - 256 + R) * D + 4 * tid) = (u32x2){cvt_pk_bf16(a.x, a.y), cvt_pk_bf16(a.z, a.w)};
    }
}
struct EpiMix {
    static constexpr bool PERM = true;
    bf16_t* C; int ldc; float* part; int pieces;
    __device__ __forceinline__ void operator()(const Acc& acc, const Unit& u, int wr, int wc, int fr, int fq) const {
        const int r0 = wr * 64 + fr;
#pragma unroll
        for (int ai = 0; ai < 2; ++ai)
#pragma unroll
            for (int m = 0; m < 4; ++m) { const int r = r0 + ai * 128 + m * 16;
#pragma unroll
                for (int bj = 0; bj < 2; ++bj) { const int colt = bj * 128 + wc * 32 + 8 * fq; const f32x4 v0 = acc[ai][bj][m][0], v1 = acc[ai][bj][m][1];
                    if (u.aux == 0) { u32x4 w; w.x = cvt_pk_bf16(v0[0], v0[1]); w.y = cvt_pk_bf16(v0[2], v0[3]); w.z = cvt_pk_bf16(v1[0], v1[1]); w.w = cvt_pk_bf16(v1[2], v1[3]);
                        *(u32x4*)(C + (size_t)(u.pm * 256 + r) * ldc + u.pn * 256 + colt) = w; }
                    else { float* d = part + (size_t)(u.pn * pieces + (u.aux - 1)) * 65536 + (size_t)r * 256 + colt; *(f32x4*)d = v0; *(f32x4*)(d + 4) = v1; } }
                asm volatile("" ::: "memory"); }
    }
};
struct EpiSwiglu {
    static constexpr bool PERM = true;
    bf16_t* hid;
    __device__ __forceinline__ void operator()(const Acc& acc, const Unit& u, int wr, int wc, int fr, int fq) const {
        const int row0 = u.pm * 256 + wr * 64 + fr; const int col = u.pn * 128 + wc * 32 + 8 * fq;
#pragma unroll
        for (int ai = 0; ai < 2; ++ai)
#pragma unroll
            for (int m = 0; m < 4; ++m) {
                float o[8];
#pragma unroll
                for (int j = 0; j < 8; ++j) { const float g = acc[ai][0][m][j >> 2][j & 3], up = acc[ai][1][m][j >> 2][j & 3]; o[j] = g * sigmoidf_(g) * up; }
                u32x4 w; w.x = cvt_pk_bf16(o[0], o[1]); w.y = cvt_pk_bf16(o[2], o[3]); w.z = cvt_pk_bf16(o[4], o[5]); w.w = cvt_pk_bf16(o[6], o[7]);
                *(u32x4*)(hid + (size_t)(row0 + ai * 128 + m * 16) * DFF + col) = w;
            }
    }
};
}

template <int MAPMODE>
__device__ __forceinline__ void transpose_item(const float* W, int K, int N, bf16_t* WT, int item, int sub, int lane) {
    const int nblk = N / 256, kb = item / nblk, nb = item - kb * nblk, n = 256 * nb + 4 * lane;
    int nn = n;
    if (MAPMODE == 1) { if (nn < DFF) nn = 256 * (nn >> 7) + (nn & 127); else { const int q = nn - DFF; nn = 256 * (q >> 7) + 128 + (q & 127); } }
    {
        const int k0 = 64 * kb + 16 * sub;
        f32x4 r[16];
#pragma unroll
        for (int e = 0; e < 16; ++e) r[e] = *(const f32x4*)(W + (size_t)(k0 + e) * N + n);
#pragma unroll
        for (int j = 0; j < 4; ++j) {
            u32x4 o0, o1;
            o0.x = cvt_pk_bf16(r[0][j], r[1][j]); o0.y = cvt_pk_bf16(r[2][j], r[3][j]); o0.z = cvt_pk_bf16(r[4][j], r[5][j]); o0.w = cvt_pk_bf16(r[6][j], r[7][j]);
            o1.x = cvt_pk_bf16(r[8][j], r[9][j]); o1.y = cvt_pk_bf16(r[10][j], r[11][j]); o1.z = cvt_pk_bf16(r[12][j], r[13][j]); o1.w = cvt_pk_bf16(r[14][j], r[15][j]);
            bf16_t* d = WT + (size_t)(nn + j) * K + k0;
            *(u32x4*)d = o0; *(u32x4*)(d + 8) = o1;
        }
    }
}

__device__ __forceinline__ void s5_gen_task(LAS unsigned char* lds, int g, int qd, const float* lam_re, const float* lam_im, const float* b_re, const float* b_im,
                                            const float* c_re, const float* c_im, const float* log_step, bf16_t* TPm, bf16_t* W1) {
    LAS float* pwr = (LAS float*)lds;
    LAS float* pwi = pwr + 33 * 64;
    LAS float* bbr = pwi + 33 * 64;
    LAS float* bbi = bbr + 1024;
    LAS float* cr = bbi + 1024;
    LAS float* ci = cr + 1024;
    LAS float* Kt = ci + 1024;
    const int tid = opaque_tid();
    __syncthreads();
    {
        const int p = tid & 63, ds = tid >> 6; const float lr = lam_re[g * 64 + p], li = lam_im[g * 64 + p], step = expf(log_step[g]);
        for (int d = ds; d <= 32; d += 8) { const float mag = expf((float)d * lr * step); float s_, c_; sincosf((float)d * li * step, &s_, &c_); pwr[d * 64 + p] = mag * c_; pwi[d * 64 + p] = mag * s_; }
        if (ds == 0) {
            const float mag = expf(lr * step); float s_, c_; sincosf(li * step, &s_, &c_); const float ar = mag * c_, aim = mag * s_;
            const float den = lr * lr + li * li; const float cre = ((ar - 1.0f) * lr + aim * li) / den, cim = (aim * lr - (ar - 1.0f) * li) / den;
            for (int cc = 0; cc < 16; ++cc) { const float br = b_re[((size_t)g * 64 + p) * 16 + cc], bi = b_im[((size_t)g * 64 + p) * 16 + cc];
                bbr[p * 16 + cc] = cre * br - cim * bi; bbi[p * 16 + cc] = cre * bi + cim * br; }
        }
    }
    for (int i = tid; i < 1024; i += 512) { cr[i] = c_re[(size_t)g * 1024 + i]; ci[i] = c_im[(size_t)g * 1024 + i]; }
    __syncthreads();
    for (int e = tid; e < 2048; e += 512) {
        const int d = e >> 6, col = (e >> 4) & 3, co = 4 * qd + col, cin = e & 15; float a = 0.f;
        for (int p = 0; p < 64; ++p) { const float pr = pwr[d * 64 + p], pi = pwi[d * 64 + p], br = bbr[p * 16 + cin], bi = bbi[p * 16 + cin];
            const float er = pr * br - pi * bi, ei = pr * bi + pi * br; a += cr[co * 64 + p] * er - ci[co * 64 + p] * ei; }
        Kt[e] = a;
    }
    __syncthreads();
    bf16_t* tp = TPm + (size_t)g * 512 * XLD;
    for (int q = tid; q < 128 * 80; q += 512) {
        const int nl = q / 80, kc = q - nl * 80, k0 = kc * 8; const int i = nl >> 2, col = nl & 3, co = 4 * qd + col, n = i * 16 + co; float v[8];
        if (k0 < 512) { const int j = k0 >> 4, cin0 = k0 & 15;
#pragma unroll
            for (int e = 0; e < 8; ++e) v[e] = (j <= i) ? Kt[(i - j) * 64 + col * 16 + cin0 + e] : 0.f;
        } else { const int p0 = (k0 - 512) >> 1;
#pragma unroll
            for (int e = 0; e < 4; ++e) { const int p = p0 + e; const float pr = pwr[(i + 1) * 64 + p], pi = pwi[(i + 1) * 64 + p], c_r = cr[co * 64 + p], c_i = ci[co * 64 + p];
                v[2 * e] = c_r * pr - c_i * pi; v[2 * e + 1] = -(c_r * pi + c_i * pr); }
        }
        u32x4 w; w.x = cvt_pk_bf16(v[0], v[1]); w.y = cvt_pk_bf16(v[2], v[3]); w.z = cvt_pk_bf16(v[4], v[5]); w.w = cvt_pk_bf16(v[6], v[7]);
        *(u32x4*)(tp + (size_t)n * XLD + k0) = w;
    }
    bf16_t* w1 = W1 + (size_t)g * 128 * 512;
    for (int q = tid; q < 32 * 64; q += 512) {
        const int n = 32 * qd + (q >> 6), kc = q & 63, k0 = kc * 8; const int p = n >> 1, r = n & 1; const int j = k0 >> 4, cin0 = k0 & 15; float v[8];
        const float pr = pwr[(31 - j) * 64 + p], pi = pwi[(31 - j) * 64 + p];
#pragma unroll
        for (int e = 0; e < 8; ++e) { const float br = bbr[p * 16 + cin0 + e], bi = bbi[p * 16 + cin0 + e]; v[e] = r ? (pr * bi + pi * br) : (pr * br - pi * bi); }
        u32x4 w; w.x = cvt_pk_bf16(v[0], v[1]); w.y = cvt_pk_bf16(v[2], v[3]); w.z = cvt_pk_bf16(v[4], v[5]); w.w = cvt_pk_bf16(v[6], v[7]);
        *(u32x4*)(w1 + (size_t)n * 512 + k0) = w;
    }
    __syncthreads();
}

#define GASF const __attribute__((address_space(1))) float
__device__ __forceinline__ void phase_norm(const Params& P, int mode, const bf16_t* src, const float* w_add, const float* w_norm, bf16_t* hbuf, bf16_t* xsb, const float* part, int pieces) {
    const int tid_ = opaque_tid(); const int lane = tid_ & 63, wave = tid_ >> 6; const int gw = blockIdx.x * 8 + wave, NGW = gridDim.x * 8;
    for (int m = gw; m < MP; m += NGW) {
        const int b = m / TP, tp = m - b * TP;
        u32x2* hrow = (u32x2*)(hbuf + (size_t)m * D) + lane;
        if (tp < PADT) { if (mode != 2) {
#pragma unroll
                for (int j = 0; j < 8; ++j) hrow[64 * j] = (u32x2){0u, 0u}; }
            continue; }
        if (mode == 2 && tp < 64) continue;
        f32x4 v[8];
        if (mode == 0 || mode == 3) {
            GASF* s0 = (tp < 64) ? (GASF*)P.in[I_META] + (size_t)(tp - PADT) * D : (GASF*)P.in[I_X] + ((size_t)b * SEQ + (tp - 64)) * D;
#pragma unroll
            for (int j = 0; j < 8; ++j) v[j] = ((const __attribute__((address_space(1))) f32x4*)s0)[lane + 64 * j];
        } else {
#pragma unroll
            for (int j = 0; j < 8; ++j) { const u32x2 w = ((const u32x2*)(xsb + (size_t)m * D))[lane + 64 * j]; v[j] = (f32x4){bf_lo(w.x), bf_hi(w.x), bf_lo(w.y), bf_hi(w.y)}; }
        }
        if (mode != 0) {
            f32x4 s[8]; float ss = 0.f;
            if (m < MP - 256) {
#pragma unroll
                for (int j = 0; j < 8; ++j) { const u32x2 w = ((const u32x2*)(src + (size_t)m * D))[lane + 64 * j]; s[j] = (f32x4){bf_lo(w.x), bf_hi(w.x), bf_lo(w.y), bf_hi(w.y)}; }
            } else {
#pragma unroll
                for (int j = 0; j < 8; ++j) s[j] = (f32x4){0.f, 0.f, 0.f, 0.f};
#pragma unroll 2
                for (int pc = 0; pc < pieces; ++pc) {
#pragma unroll
                    for (int j = 0; j < 8; ++j) s[j] += ((const f32x4*)(part + ((size_t)(j * pieces + pc) * 256 + (m - (MP - 256))) * 256))[lane];
                }
            }
#pragma unroll
            for (int j = 0; j < 8; ++j) ss += (s[j].x * s[j].x + s[j].y * s[j].y) + (s[j].z * s[j].z + s[j].w * s[j].w);
            const float r = rsqrtf(wave_sum(ss) * (1.0f / D) + 1e-6f);
#pragma unroll
            for (int j = 0; j < 8; ++j) { const f32x4 w = ((const f32x4*)w_add)[lane + 64 * j]; v[j] += s[j] * r * w; }
            if (mode == 2) {
                __attribute__((address_space(1))) f32x4* o = (__attribute__((address_space(1))) f32x4*)((__attribute__((address_space(1))) float*)P.out + ((size_t)b * SEQ + (tp - 64)) * D);
#pragma unroll
                for (int j = 0; j < 8; ++j) o[lane + 64 * j] = v[j];
                continue;
            }
#pragma unroll
            for (int j = 0; j < 8; ++j) ((u32x2*)(xsb + (size_t)m * D))[lane + 64 * j] = (u32x2){cvt_pk_bf16(v[j].x, v[j].y), cvt_pk_bf16(v[j].z, v[j].w)};
        }
        float ss = 0.f;
#pragma unroll
        for (int j = 0; j < 8; ++j) ss += (v[j].x * v[j].x + v[j].y * v[j].y) + (v[j].z * v[j].z + v[j].w * v[j].w);
        const float r = rsqrtf(wave_sum(ss) * (1.0f / D) + 1e-6f);
#pragma unroll
        for (int j = 0; j < 8; ++j) { const f32x4 w = ((const f32x4*)w_norm)[lane + 64 * j]; const f32x4 o = v[j] * r * w;
            hrow[64 * j] = (u32x2){cvt_pk_bf16(o.x, o.y), cvt_pk_bf16(o.z, o.w)}; }
    }
}

__device__ __forceinline__ void phase_prep(LAS unsigned char* lds, const bf16_t* p5, bf16_t* xc, bf16_t* vt, const float* cw, const float* cb) {
    const int tid = opaque_tid(); const int gt = blockIdx.x * 512 + tid, NGT = gridDim.x * 512;
    for (int it = gt; it < MP * 128; it += NGT) {
        const int m = it >> 7, c0 = (it & 127) * 8; float o[8];
#pragma unroll
        for (int j = 0; j < 8; ++j) o[j] = cb[c0 + j];
#pragma unroll
        for (int k = 0; k < 4; ++k) { const int mm = m - 3 + k; if (mm >= 0) {
                const u32x4 a = *(const u32x4*)(p5 + (size_t)mm * LDP + C_AX + c0);
                const float av[8] = {bf_lo(a.x), bf_hi(a.x), bf_lo(a.y), bf_hi(a.y), bf_lo(a.z), bf_hi(a.z), bf_lo(a.w), bf_hi(a.w)};
#pragma unroll
                for (int j = 0; j < 8; ++j) o[j] += cw[k * 1024 + c0 + j] * av[j]; } }
        u32x4 w; w.x = cvt_pk_bf16(o[0], o[1]); w.y = cvt_pk_bf16(o[2], o[3]); w.z = cvt_pk_bf16(o[4], o[5]); w.w = cvt_pk_bf16(o[6], o[7]);
        *(u32x4*)(xc + (size_t)m * 1024 + c0) = w;
    }
    LAS bf16_t* tl = (LAS bf16_t*)lds;
    for (int it = blockIdx.x; it < 32 * 65; it += gridDim.x) {
        const int bh = it / 65, tb = it - bh * 65, b = bh >> 3, h = bh & 7;
        __syncthreads();
#pragma unroll
        for (int i = 0; i < 2; ++i) { const int id = tid + 512 * i, row = id >> 4, c16 = id & 15;
            const u32x4 a = *(const u32x4*)(p5 + ((size_t)b * TP + tb * 64 + row) * LDP + C_V + h * 128 + c16 * 8);
            LAS unsigned* d = (LAS unsigned*)(tl + row * 130 + c16 * 8); d[0] = a.x; d[1] = a.y; d[2] = a.z; d[3] = a.w; }
        __syncthreads();
#pragma unroll
        for (int i = 0; i < 2; ++i) { const int id = tid + 512 * i, dv = id >> 3, c8 = id & 7; unsigned short e[8];
#pragma unroll
            for (int j = 0; j < 8; ++j) e[j] = tl[(c8 * 8 + j) * 130 + dv];
            u32x4 w; w.x = e[0] | ((unsigned)e[1] << 16); w.y = e[2] | ((unsigned)e[3] << 16); w.z = e[4] | ((unsigned)e[5] << 16); w.w = e[6] | ((unsigned)e[7] << 16);
            *(u32x4*)(vt + ((size_t)bh * 128 + dv) * TP + tb * 64 + c8 * 8) = w; }
    }
    __syncthreads();
}

__device__ __forceinline__ void lru_scan1(const bf16_t* p5, const bf16_t* bbuf, float* agg) {
    const int gt = blockIdx.x * 512 + opaque_tid(), NGT = gridDim.x * 512;
    for (int it = gt; it < NB * NCH64 * 512; it += NGT) {
        const int cp = it & 511, bc = it >> 9; const int b = bc / NCH64, c = bc - b * NCH64; const size_t m0 = (size_t)b * TP + c * 64;
        float s0 = 0.f, s1 = 0.f, h0 = 0.f, h1 = 0.f;
        for (int t0 = 0; t0 < 64; t0 += 32) {
            unsigned lw[32], bw[32];
#pragma unroll
            for (int k = 0; k < 32; ++k) { lw[k] = *(const unsigned*)(p5 + (m0 + t0 + k) * LDP + C_AX + 2 * cp); bw[k] = *(const unsigned*)(bbuf + (m0 + t0 + k) * 1024 + 2 * cp); }
#pragma unroll
            for (int k = 0; k < 32; ++k) { const float l0 = bf_lo(lw[k]), l1 = bf_hi(lw[k]); s0 += l0; s1 += l1; h0 = __expf(l0) * h0 + bf_lo(bw[k]); h1 = __expf(l1) * h1 + bf_hi(bw[k]); }
        }
        *(f32x4*)(agg + ((size_t)bc * 512 + cp) * 4) = (f32x4){s0, h0, s1, h1};
    }
}
__device__ __forceinline__ void lru_scan2(bf16_t* p5, const bf16_t* bbuf, const float* agg) {
    const int gt = blockIdx.x * 512 + opaque_tid(), NGT = gridDim.x * 512;
    for (int it = gt; it < NB * NCH64 * 512; it += NGT) {
        const int cp = it & 511, bc = it >> 9; const int b = bc / NCH64, c = bc - b * NCH64; const size_t m0 = (size_t)b * TP + c * 64;
        float h0 = 0.f, h1 = 0.f;
        for (int cc0 = 0; cc0 < c; cc0 += 16) {
            f32x4 a[16];
#pragma unroll
            for (int k = 0; k < 16; ++k) a[k] = (cc0 + k < c) ? *(const f32x4*)(agg + ((size_t)(b * NCH64 + cc0 + k) * 512 + cp) * 4) : (f32x4){0.f, 0.f, 0.f, 0.f};
#pragma unroll
            for (int k = 0; k < 16; ++k) { h0 = __expf(a[k].x) * h0 + a[k].y; h1 = __expf(a[k].z) * h1 + a[k].w; }
        }
        for (int t0 = 0; t0 < 64; t0 += 16) {
            unsigned lw[16], bw[16], gw[16];
#pragma unroll
            for (int k = 0; k < 16; ++k) { lw[k] = *(const unsigned*)(p5 + (m0 + t0 + k) * LDP + C_AX + 2 * cp); bw[k] = *(const unsigned*)(bbuf + (m0 + t0 + k) * 1024 + 2 * cp);
                gw[k] = *(const unsigned*)(p5 + (m0 + t0 + k) * LDP + C_AG + 2 * cp); }
#pragma unroll
            for (int k = 0; k < 16; ++k) { h0 = __expf(bf_lo(lw[k])) * h0 + bf_lo(bw[k]); h1 = __expf(bf_hi(lw[k])) * h1 + bf_hi(bw[k]);
                gw[k] = cvt_pk_bf16(h0 * gelu_tanh(bf_lo(gw[k])), h1 * gelu_tanh(bf_hi(gw[k]))); }
#pragma unroll
            for (int k = 0; k < 16; ++k) *(unsigned*)(p5 + (m0 + t0 + k) * LDP + C_AG + 2 * cp) = gw[k];
        }
    }
}
__device__ __forceinline__ void s5_carry(bf16_t* xh, const float* sb, const float* lam_re, const float* lam_im, const float* log_step) {
    const int gt = blockIdx.x * 512 + opaque_tid(), NGT = gridDim.x * 512;
    for (int it = gt; it < NB * 64 * 64; it += NGT) {
        const int p = it & 63, g = (it >> 6) & 63, b = it >> 12;
        const float lr = lam_re[g * 64 + p], li = lam_im[g * 64 + p], step = expf(log_step[g]);
        const float mag = expf(32.0f * lr * step); float s, c; sincosf(32.0f * li * step, &s, &c); const float ar = mag * c, ai = mag * s;
        float hr = 0.f, hi = 0.f;
        for (int ch0 = 0; ch0 < NCH32; ch0 += 26) {
            const size_t row0 = (size_t)g * XROWS + b * NCH32 + ch0; f32x2 sv[26];
#pragma unroll
            for (int k = 0; k < 26; ++k) sv[k] = *(const f32x2*)(sb + (row0 + k) * 128 + 2 * p);
#pragma unroll
            for (int k = 0; k < 26; ++k) {
                *(unsigned*)(xh + (row0 + k) * XLD + 512 + 2 * p) = cvt_pk_bf16(hr, hi);
                const float nr = ar * hr - ai * hi + sv[k].x, ni = ar * hi + ai * hr + sv[k].y; hr = nr; hi = ni; }
        }
    }
}

__device__ __forceinline__ float rows4_max(float v) {
    unsigned a = __float_as_uint(v); auto r = __builtin_amdgcn_permlane16_swap(a, a, false, false); v = fmaxf(__uint_as_float(r[0]), __uint_as_float(r[1]));
    a = __float_as_uint(v); auto r2 = __builtin_amdgcn_permlane32_swap(a, a, false, false); return fmaxf(__uint_as_float(r2[0]), __uint_as_float(r2[1])); }
__device__ __forceinline__ float rows4_sum(float v) {
    unsigned a = __float_as_uint(v); auto r = __builtin_amdgcn_permlane16_swap(a, a, false, false); v = __uint_as_float(r[0]) + __uint_as_float(r[1]);
    a = __float_as_uint(v); auto r2 = __builtin_amdgcn_permlane32_swap(a, a, false, false); return __uint_as_float(r2[0]) + __uint_as_float(r2[1]); }
constexpr int KPITCH = 272, VPITCH = 144, KBYTES = 64 * KPITCH, VBYTES = 128 * VPITCH;
__device__ __forceinline__ void attn_phase(LAS unsigned char* lds, bf16_t* p5, const bf16_t* vt, const float* relb, const float* dalam, const float* subln, float lam_init, int ocol) {
    const int tid = opaque_tid(), lane = tid & 63, wave = __builtin_amdgcn_readfirstlane(tid >> 6), lq = lane & 15, g4 = lane >> 4;
    const int cc = wave & 1, rgi = wave >> 1;
    LAS float* btab = (LAS float*)(lds + 2 * KBYTES + 2 * VBYTES);
    float lam;
    { float s1 = 0.f, s2 = 0.f; for (int i = 0; i < 64; ++i) { s1 += dalam[i] * dalam[64 + i]; s2 += dalam[128 + i] * dalam[192 + i]; } lam = expf(s1) - expf(s2) + lam_init; }
    const int c = blockIdx.x, G = gridDim.x;
    const float sc2 = 0.125f * LOG2E;
    for (int r = 0;; ++r) {
        const int idx = (r & 1) ? r * G + (G - 1 - c) : r * G + c;
        if (r * G >= 33 * 32) break;
        if (idx >= 33 * 32) continue;
        const int qt = 32 - idx / 32, bh = idx & 31, b = bh >> 3, h = bh & 7;
        const int njt = (2 * qt + 2) < 65 ? (2 * qt + 2) : 65;
        const int qrow0 = qt * 128 + rgi * 32;
        __syncthreads();
        if (tid < 128) { const int d = tid; int bk = d; if (d >= 16) { bk = 16 + (int)(logf((float)d * (1.0f / 16.0f)) * (16.0f / logf(8.0f))); if (bk > 31) bk = 31; } btab[d] = relb[bk * 8 + h] * LOG2E; }
        const float bfar = relb[31 * 8 + h] * LOG2E;
        bf16x8 qf[2][2];
#pragma unroll
        for (int rg = 0; rg < 2; ++rg) { const int q = qrow0 + 16 * rg + lq, qc = q < TP ? q : TP - 1;
#pragma unroll
            for (int s = 0; s < 2; ++s) qf[rg][s] = *(const bf16x8*)(p5 + ((size_t)b * TP + qc) * LDP + C_Q + h * 128 + cc * 64 + s * 32 + 8 * g4); }
        f32x4 O[2][8]; float mrow[2], lrow[2];
#pragma unroll
        for (int rg = 0; rg < 2; ++rg) { mrow[rg] = -INFINITY; lrow[rg] = 0.f;
#pragma unroll
            for (int k = 0; k < 8; ++k) O[rg][k] = (f32x4){0.f, 0.f, 0.f, 0.f}; }
        u32x4 kreg[2], vreg[2];
        const bf16_t* kbase = p5 + (size_t)b * TP * LDP + C_K + h * 128; const bf16_t* vbase = vt + (size_t)bh * 128 * TP;
#define ATT_LOAD(j) do { _Pragma("unroll") for (int i = 0; i < 2; ++i) { const int id = tid + 512 * i; \
            kreg[i] = *(const u32x4*)(kbase + (size_t)((j) * 64 + (id >> 4)) * LDP + (id & 15) * 8); \
            vreg[i] = *(const u32x4*)(vbase + (size_t)(id >> 3) * TP + (j) * 64 + (id & 7) * 8); } } while (0)
#define ATT_STORE(buf) do { _Pragma("unroll") for (int i = 0; i < 2; ++i) { const int id = tid + 512 * i; \
            *(LAS u32x4*)(lds + (buf) * KBYTES + (id >> 4) * KPITCH + (id & 15) * 16) = kreg[i]; \
            *(LAS u32x4*)(lds + 2 * KBYTES + (buf) * VBYTES + (id >> 3) * VPITCH + (id & 7) * 16) = vreg[i]; } } while (0)
        ATT_LOAD(0); ATT_STORE(0); __syncthreads();
        for (int j = 0; j < njt; ++j) {
            if (j + 1 < njt) ATT_LOAD(j + 1);
            if (j * 64 <= qrow0 + 31) {
                const LAS unsigned char* kb_ = lds + (j & 1) * KBYTES; const LAS unsigned char* vb_ = lds + 2 * KBYTES + (j & 1) * VBYTES;
                bf16x8 kf[4][2];
#pragma unroll
                for (int kb = 0; kb < 4; ++kb)
#pragma unroll
                    for (int s = 0; s < 2; ++s) kf[kb][s] = *(const LAS bf16x8*)(kb_ + (16 * kb + lq) * KPITCH + (cc * 64 + s * 32 + 8 * g4) * 2);
                __builtin_amdgcn_sched_barrier(0);
                f32x4 st[2][4];
#pragma unroll
                for (int kb = 0; kb < 4; ++kb)
#pragma unroll
                    for (int rg = 0; rg < 2; ++rg) { f32x4 a = (f32x4){0.f, 0.f, 0.f, 0.f};
#pragma unroll
                        for (int s = 0; s < 2; ++s) a = __builtin_amdgcn_mfma_f32_16x16x32_bf16(kf[kb][s], qf[rg][s], a, 0, 0, 0);
                        st[rg][kb] = a; }
                __builtin_amdgcn_sched_barrier(0);
#define ATT_VLOAD(dst, k0, nk) _Pragma("unroll") for (int k = 0; k < (nk); ++k) _Pragma("unroll") for (int s = 0; s < 2; ++s) { \
                    const LAS unsigned char* vp = vb_ + (16 * (k + (k0)) + lq) * VPITCH + (32 * s + 4 * g4) * 2; dst[k][s][0] = *(const LAS u32x2*)vp; dst[k][s][1] = *(const LAS u32x2*)(vp + 32); }
#define ATT_PV(src, k0, nk) _Pragma("unroll") for (int k = 0; k < (nk); ++k) _Pragma("unroll") for (int s = 0; s < 2; ++s) { \
                    const bf16x8 vf = __builtin_bit_cast(bf16x8, (u32x4){src[k][s][0].x, src[k][s][0].y, src[k][s][1].x, src[k][s][1].y}); \
                    O[0][k + (k0)] = __builtin_amdgcn_mfma_f32_16x16x32_bf16(vf, pk[0][s], O[0][k + (k0)], 0, 0, 0); \
                    O[1][k + (k0)] = __builtin_amdgcn_mfma_f32_16x16x32_bf16(vf, pk[1][s], O[1][k + (k0)], 0, 0, 0); }
                u32x2 va[1][2][2];
                ATT_VLOAD(va, 0, 1)
                __builtin_amdgcn_sched_barrier(0);
                const bool far = (j >= 1) && (j * 64 + 63 + 113 <= qrow0);
                bf16x8 pk[2][2];
#pragma unroll
                for (int rg = 0; rg < 2; ++rg) {
                    float rmax = -INFINITY, msafe, alpha;
                    if (far) {
#pragma unroll
                        for (int kb = 0; kb < 4; ++kb)
#pragma unroll
                            for (int i = 0; i < 4; ++i) rmax = fmaxf(rmax, st[rg][kb][i]);
                        rmax = rows4_max(rmax);
                        const float mnew = fmaxf(mrow[rg], rmax * sc2 + bfar); msafe = mnew;
                        alpha = __builtin_amdgcn_exp2f(mrow[rg] - msafe); mrow[rg] = mnew;
                        const float off = bfar - msafe;
#pragma unroll
                        for (int kb = 0; kb < 4; ++kb)
#pragma unroll
                            for (int i = 0; i < 4; ++i) st[rg][kb][i] = __builtin_amdgcn_exp2f(st[rg][kb][i] * sc2 + off);
                    } else {
                        const int q = qrow0 + 16 * rg + lq;
#pragma unroll
                        for (int kb = 0; kb < 4; ++kb)
#pragma unroll
                            for (int i = 0; i < 4; ++i) { float v = st[rg][kb][i] * sc2;
                                const int kp = j * 64 + 16 * kb + 4 * g4 + i; const int dist = q - kp;
                                const float bv = (dist >= 0 && dist < 128) ? btab[dist] : bfar;
                                v = (kp >= PADT && dist >= 0) ? v + bv : -INFINITY;
                                st[rg][kb][i] = v; rmax = fmaxf(rmax, v); }
                        rmax = rows4_max(rmax);
                        const float mnew = fmaxf(mrow[rg], rmax); msafe = (mnew == -INFINITY) ? 0.f : mnew;
                        alpha = __builtin_amdgcn_exp2f(mrow[rg] - msafe); mrow[rg] = mnew;
#pragma unroll
                        for (int kb = 0; kb < 4; ++kb)
#pragma unroll
                            for (int i = 0; i < 4; ++i) st[rg][kb][i] = __builtin_amdgcn_exp2f(st[rg][kb][i] - msafe);
                    }
                    float rs = 0.f;
#pragma unroll
                    for (int kb = 0; kb < 4; ++kb) rs += (st[rg][kb][0] + st[rg][kb][1]) + (st[rg][kb][2] + st[rg][kb][3]);
                    lrow[rg] = lrow[rg] * alpha + rs;
                    if (__builtin_amdgcn_ballot_w64(alpha != 1.0f) != 0ull) {
#pragma unroll
                        for (int k = 0; k < 8; ++k) O[rg][k] *= alpha; }
#pragma unroll
                    for (int s = 0; s < 2; ++s) { u32x4 w; w.x = cvt_pk_bf16(st[rg][2 * s][0], st[rg][2 * s][1]); w.y = cvt_pk_bf16(st[rg][2 * s][2], st[rg][2 * s][3]);
                        w.z = cvt_pk_bf16(st[rg][2 * s + 1][0], st[rg][2 * s + 1][1]); w.w = cvt_pk_bf16(st[rg][2 * s + 1][2], st[rg][2 * s + 1][3]);
                        pk[rg][s] = __builtin_bit_cast(bf16x8, w); }
                }
                __builtin_amdgcn_sched_barrier(0);
                u32x2 vc[3][2][2];
                ATT_VLOAD(vc, 1, 3)
                __builtin_amdgcn_sched_barrier(0);
                ATT_PV(va, 0, 1)
                __builtin_amdgcn_sched_barrier(0);
                u32x2 vd[2][2][2];
                ATT_VLOAD(vd, 4, 2)
                __builtin_amdgcn_sched_barrier(0);
                ATT_PV(vc, 1, 3)
                __builtin_amdgcn_sched_barrier(0);
                u32x2 ve[2][2][2];
                ATT_VLOAD(ve, 6, 2)
                __builtin_amdgcn_sched_barrier(0);
                ATT_PV(vd, 4, 2)
                __builtin_amdgcn_sched_barrier(0);
                ATT_PV(ve, 6, 2)
#undef ATT_VLOAD
#undef ATT_PV
            }
            if (j + 1 < njt) ATT_STORE((j + 1) & 1);
            __syncthreads();
        }
#undef ATT_LOAD
#undef ATT_STORE
        LAS f32x4* xch = (LAS f32x4*)lds + (size_t)rgi * 2 * 8 * 64 + lane;
#pragma unroll
        for (int rg = 0; rg < 2; ++rg) { const float l_ = rows4_sum(lrow[rg]); const float f = l_ > 0.f ? (cc ? lam : 1.0f) / l_ : 0.f;
#pragma unroll
            for (int k = 0; k < 8; ++k) { O[rg][k] *= f; if (cc) xch[(rg * 8 + k) * 64] = O[rg][k]; } }
        __syncthreads();
        if (cc == 0) {
#pragma unroll
            for (int rg = 0; rg < 2; ++rg) { const int q = qrow0 + 16 * rg + lq; float ss = 0.f;
#pragma unroll
                for (int k = 0; k < 8; ++k) { O[rg][k] -= xch[(rg * 8 + k) * 64]; ss += (O[rg][k].x * O[rg][k].x + O[rg][k].y * O[rg][k].y) + (O[rg][k].z * O[rg][k].z + O[rg][k].w * O[rg][k].w); }
                ss = rows4_sum(ss);
                const float rn = rsqrtf(ss * (1.0f / 128.0f) + 1e-5f) * (1.0f - lam_init);
                if (q < TP) {
#pragma unroll
                    for (int k = 0; k < 8; ++k) { const f32x4 w = *(const f32x4*)(subln + 16 * k + 4 * g4); const f32x4 o = O[rg][k] * rn * w;
                        *(u32x2*)(p5 + ((size_t)b * TP + q) * LDP + ocol + h * 128 + 16 * k + 4 * g4) = (u32x2){cvt_pk_bf16(o.x, o.y), cvt_pk_bf16(o.z, o.w)}; }
                }
            }
        }
    }
    __syncthreads();
}

#define XB_TMO      128
#define XB_XCNT(j)  (256  + 64 * (j))
#define XB_XSUB(j)  (1280 + 64 * (j))
#define XB_XGEN(j)  (2304 + 64 * (j))
#define XB_TOP      3328
#define XB_TOPGEN   3392
#define XCD_BAR_WORDS 3456
#define XB_SPIN_CAP (1u << 20)
__device__ __forceinline__ unsigned xb_ld(unsigned* p)              { return __hip_atomic_load(p, __ATOMIC_RELAXED, __HIP_MEMORY_SCOPE_AGENT); }
__device__ __forceinline__ unsigned xb_add(unsigned* p, unsigned v) { return __hip_atomic_fetch_add(p, v, __ATOMIC_RELAXED, __HIP_MEMORY_SCOPE_AGENT); }
__device__ __forceinline__ unsigned xb_xcc_id() { return (unsigned)__builtin_amdgcn_s_getreg((3 << 11) | 20) & 0xFu; }
#define XB_SPIN(cond, bar) do { unsigned _sp = 0; while (cond) { __builtin_amdgcn_s_sleep(1); \
    if ((++_sp & 255u) == 0u) { if (xb_ld(&(bar)[XB_TMO])) break; if (_sp > XB_SPIN_CAP) { atomicAdd(&(bar)[XB_TMO], 1u); break; } } } } while (0)
struct XcdBarrier { unsigned* bar; unsigned x; volatile LAS unsigned* st; };
__device__ __forceinline__ XcdBarrier xcd_barrier_post(unsigned* bar, volatile LAS unsigned* st) {
    XcdBarrier b; b.bar = bar; b.x = xb_xcc_id(); b.st = st;
    if (threadIdx.x == 0) (void)xb_add(&bar[XB_XCNT(b.x)], 1u);
    return b;
}
__device__ __forceinline__ void xcd_barrier_complete(unsigned* bar, unsigned x, unsigned& nloc, unsigned& nx) {
    const unsigned G = gridDim.x * gridDim.y * gridDim.z;
    unsigned sum, cnt, mine, sp = 0u;
    for (;;) {
        sum = 0u; cnt = 0u; mine = 0u;
#pragma unroll
        for (unsigned j = 0; j < 16; ++j) { const unsigned c = xb_ld(&bar[XB_XCNT(j)]); sum += c; cnt += (c > 0u) ? 1u : 0u; mine = (j == x) ? c : mine; }
        if (sum == G) break;
        __builtin_amdgcn_s_sleep(1);
        if ((++sp & 255u) == 0u) { if (xb_ld(&bar[XB_TMO])) break; if (sp > XB_SPIN_CAP) { atomicAdd(&bar[XB_TMO], 1u); break; } }
    }
    nloc = mine > 0u ? mine : 1u; nx = cnt > 0u ? cnt : 1u;
}
__device__ __forceinline__ void xcd_barrier(const XcdBarrier& b) {
    asm volatile("s_waitcnt vmcnt(0)" ::: "memory");
    __syncthreads();
    if (threadIdx.x == 0) {
        unsigned* bar = b.bar;
        __builtin_amdgcn_s_waitcnt(0);
        unsigned nloc = b.st[0], nx = b.st[1];
        if (nloc == 0u) { xcd_barrier_complete(bar, b.x, nloc, nx); b.st[0] = nloc; b.st[1] = nx; }
        const unsigned old = xb_add(&bar[XB_XSUB(b.x)], 1u);
        const unsigned gen = old / nloc;
        if (old + 1u == (gen + 1u) * nloc) {
            __builtin_amdgcn_fence(__ATOMIC_RELEASE, "agent");
            asm volatile("s_waitcnt vmcnt(0)" ::: "memory");
            const unsigned og = xb_add(&bar[XB_TOP], 1u);
            const unsigned tg = og / nx;
            if (og + 1u == (tg + 1u) * nx) xb_add(&bar[XB_TOPGEN], 1u);
            else XB_SPIN(xb_ld(&bar[XB_TOPGEN]) == tg, bar);
            __builtin_amdgcn_fence(__ATOMIC_ACQUIRE, "agent");
            xb_add(&bar[XB_XGEN(b.x)], 1u);
            asm volatile("s_waitcnt vmcnt(0)" ::: "memory");
        } else {
            XB_SPIN(xb_ld(&bar[XB_XGEN(b.x)]) == gen, bar);
            __builtin_amdgcn_fence(__ATOMIC_ACQUIRE, "agent");
            asm volatile("s_waitcnt vmcnt(0)" ::: "memory");
        }
    }
    __syncthreads();
}

#ifndef PROBE_DUP
#define PROBE_DUP 0
#endif
#ifndef PHM
#define PHM 0xFFFF
#endif
#define PH(b) if ((PHM >> (b)) & 1)
#define HB ((bf16_t*)(ws + WS_H))
#define P5 ((bf16_t*)(ws + WS_P5))
#define GT ((bf16_t*)(ws + WS_GT))
#define XC ((bf16_t*)(ws + WS_XC))
#define VT ((bf16_t*)(ws + WS_VT))
#define XH ((bf16_t*)(ws + WS_XH))
#define SB ((float*)(ws + WS_SB))
#define TPM ((bf16_t*)(ws + WS_TP))
#define W1M ((bf16_t*)(ws + WS_W1))
#define XSB ((bf16_t*)(ws + WS_XS))
#define AGG ((float*)(ws + WS_AGG))
#define LSG ((float*)(ws + WS_LSG))
#define MIX ((bf16_t*)(ws + WS_GT))
#define PART ((float*)(ws + WS_VT))
#define PART2 ((float*)(ws + WS_XC))
#define HID ((bf16_t*)(ws + WS_GT))
#define FFO ((bf16_t*)(ws + WS_P5))
#define WIN ((bf16_t*)(ws + WS_W + W_IN))
#define WBR ((bf16_t*)(ws + WS_W + W_BR))
#define WOUT ((bf16_t*)(ws + WS_W + W_OUT))
#define WGLU ((bf16_t*)(ws + WS_W + W_GLU))
#define WLRU ((bf16_t*)(ws + WS_W + W_LRU))
#define WF1 ((bf16_t*)(ws + WS_W + W_F1))
#define WF2 ((bf16_t*)(ws + WS_W + W_F2))
#define GASP __attribute__((address_space(1)))
#define PIN(i) ((const float*)(const GASP float*)(P.in[(i) + z]))
#define PHASE_BEGIN unsigned char* ws = opaque_ptr(P.ws); const int z = opaque_zero(); (void)ws; (void)z;
#define GSYNC() xcd_barrier(xbar)
constexpr int LDS_BYTES = 131072 + 1024;
__global__ void __launch_bounds__(512, 2) mega_fwd(Params P) {
    extern __shared__ __attribute__((aligned(16))) unsigned char lds_raw[];
    LAS unsigned char* lds = (LAS unsigned char*)lds_raw;
    cg::grid_group grid = cg::this_grid();
    const int G = gridDim.x, c = blockIdx.x;
    volatile LAS unsigned* bst = (volatile LAS unsigned*)(lds + 131072 + 512);
    if (threadIdx.x < 2) bst[threadIdx.x] = 0u;
    if (c == 0) for (int i = threadIdx.x; i < XCD_BAR_WORDS; i += 512) __hip_atomic_store((unsigned*)(P.ws + WS_BAR) + i, 0u, __ATOMIC_RELAXED, __HIP_MEMORY_SCOPE_AGENT);
    grid.sync();
    const XcdBarrier xbar = xcd_barrier_post((unsigned*)(P.ws + WS_BAR), bst);
    for (int l = 0; l < 2; ++l) {
        PH(0) { PHASE_BEGIN
            phase_norm(P, l == 0 ? 0 : 1, FFO, PIN(I_NORMW) + 3 * D, PIN(I_NORMW) + (size_t)l * 4 * D, HB, XSB, PART, 11); }
        for (int rep_ = 0; rep_ < ((PROBE_DUP & 16) ? 2 : 1); ++rep_) PH(1) { PHASE_BEGIN
            const int tid = opaque_tid(), lane = tid & 63, wave = __builtin_amdgcn_readfirstlane(tid >> 6); const int gw = c * 8 + wave, NGW = (G + z) * 8;
            const float* win = PIN(I_WIN) + (size_t)l * D * 12288; const float* wbr = PIN(I_WBR) + (size_t)l * 3 * 1024 * D; const float* wout = PIN(I_WOUT) + (size_t)l * D * D;
            const float* wglu = PIN(I_S5WG) + (size_t)l * 1024 * 1024;
            const int n_in = 32 * 48, n_br = 16 * 8, n_out = 32 * 8, n_glu = 16 * 4; const int tot = n_in + 3 * n_br + n_out + n_glu;
            { const int tot4 = tot * 4; const int s0 = (int)((unsigned)(gw * tot4) / (unsigned)NGW), s1 = (int)((unsigned)((gw + 1) * tot4) / (unsigned)NGW);
            for (int ss = s0; ss < s1; ++ss) {
                int r = ss >> 2; const int sub = ss & 3;
                if (r < n_in) { transpose_item<0>(win, D, 12288, WIN, r, sub, lane); continue; } r -= n_in;
                if (r < 3 * n_br) { const int i = r / n_br; transpose_item<0>(wbr + (size_t)i * 1024 * D, 1024, D, WBR + (size_t)i * D * 1024, r - i * n_br, sub, lane); continue; } r -= 3 * n_br;
                if (r < n_out) { transpose_item<0>(wout, D, D, WOUT, r, sub, lane); continue; } r -= n_out;
                transpose_item<0>(wglu, 1024, 1024, WGLU, r, sub, lane);
            } }
            const float* wa = PIN(I_LWA) + (size_t)l * 8 * 128 * 128; const float* wx = PIN(I_LWX) + (size_t)l * 8 * 128 * 128;
            for (int e = c * 512 + tid; e < 8 * 256 * 256; e += G * 512) { const int k = e & 255, n = (e >> 8) & 255, hh = e >> 16; float v = 0.f;
                if (k < 128) v = (n < 128) ? wa[((size_t)hh * 128 + k) * 128 + n] : wx[((size_t)hh * 128 + k) * 128 + (n - 128)];
                WLRU[e] = (bf16_t)(cvt_pk_bf16(v, 0.f) & 0xffffu); }
            if (c == 0) for (int e = tid; e < 1024; e += 512) LSG[e] = -8.0f * log1pf(expf(-(PIN(I_LLAM) + (size_t)l * 1024)[e]));
            __syncthreads();
            for (int t = c; t < 256; t += G)
                s5_gen_task(lds, t >> 2, t & 3, PIN(I_S5LR) + l * 4096, PIN(I_S5LI) + l * 4096, PIN(I_S5BR) + (size_t)l * 65536, PIN(I_S5BI) + (size_t)l * 65536,
                             PIN(I_S5CR) + (size_t)l * 65536, PIN(I_S5CI) + (size_t)l * 65536, PIN(I_S5LS) + l * 64, TPM, W1M);
        }
        GSYNC();
        PH(2) { PHASE_BEGIN
          pg8::DenseOrder S{HB, WIN, D, D, MP / 256, 12288 / 256, G, c, D / 64}; pg8::EpiG1 E{P5, XH, GT, PIN(I_BGATE) + (size_t)l * NGATE};
#if PROBE_DUP & 1
          pg8::gemm_phase(lds, D, D, S, E);
#endif
          pg8::gemm_phase(lds, D, D, S, E); }
        GSYNC();
        for (int rep_ = 0; rep_ < ((PROBE_DUP & 64) ? 2 : 1); ++rep_) PH(3) { PHASE_BEGIN
          phase_prep(lds, P5, XC, VT, PIN(I_CONVW) + (size_t)l * 4096, PIN(I_CONVB) + (size_t)l * 1024); }
        GSYNC();
        PH(4) { PHASE_BEGIN
          pg8::GroupOrder S{XC, WLRU, 1024, 256, MP / 256, 1, 8, 0, 256, 128, G, c, 4};
          pg8::EpiLru E{P5, XC, PIN(I_LBA) + (size_t)l * 1024, PIN(I_LBX) + (size_t)l * 1024, LSG};
          pg8::gemm_phase(lds, 1024, 256, S, E); }
        PH(5) { PHASE_BEGIN
          pg8::GroupOrder S{XH, W1M, XLD, 512, 3, 1, 64, XROWS, 128, 0, G, c, 8}; pg8::EpiS5S E{SB};
          pg8::gemm_phase(lds, XLD, 512, S, E); }
        PH(6) { PHASE_BEGIN
          const float lam_init = 0.8f - 0.6f * expf(-0.3f * (float)l);
#if PROBE_DUP & 2
          attn_phase(lds, P5, VT, PIN(I_RELB), PIN(I_DALAM) + (size_t)l * 256, PIN(I_DASUB) + (size_t)l * 128, lam_init, C_V);
#endif
          attn_phase(lds, P5, VT, PIN(I_RELB), PIN(I_DALAM) + (size_t)l * 256, PIN(I_DASUB) + (size_t)l * 128, lam_init, C_Q); }
        GSYNC();
        for (int rep_ = 0; rep_ < ((PROBE_DUP & 128) ? 2 : 1); ++rep_) PH(7) { PHASE_BEGIN
          lru_scan1(P5, XC, AGG);
          s5_carry(XH, SB, PIN(I_S5LR) + l * 4096, PIN(I_S5LI) + l * 4096, PIN(I_S5LS) + l * 64); }
        GSYNC();
        PH(8) { PHASE_BEGIN
          pg8::GroupOrder S{XH, TPM, XLD, XLD, 3, 2, 64, XROWS, 512, 0, G, c, 10}; pg8::EpiS5Y E{P5, XH, PIN(I_S5D) + (size_t)l * 1024};
          pg8::gemm_phase(lds, XLD, XLD, S, E); }
        PH(7) { PHASE_BEGIN
          lru_scan2(P5, XC, AGG); }
        GSYNC();
        PH(9) { PHASE_BEGIN
          pg8::DenseOrder S{P5 + C_V, WGLU, LDP, 1024, MP / 256, 4, G, c, 16}; pg8::EpiGlu E{P5, PIN(I_S5BG) + (size_t)l * 1024};
          pg8::gemm_phase(lds, LDP, 1024, S, E); }
        GSYNC();
        PH(10) { PHASE_BEGIN
          pg8::BranchOrder S{P5, WBR, LDP, 1024, MP / 256, 8, G, c, 16, 4}; pg8::EpiG2 E{GT, (u32x4*)(ws + WS_XH) + (size_t)c * 16 * 512, HB, PART2, 4};
          pg8::gemm_phase(lds, LDP, 1024, S, E); }
        GSYNC();
        PH(10) { PHASE_BEGIN
          pg8::g2_tail_reduce(PART2, 4, HB); }
        GSYNC();
        PH(11) { PHASE_BEGIN
          pg8::SplitOrder S{HB, WOUT, D, D, MP / 256, 8, G, c, D / 64, 4, 8}; pg8::EpiMix E{MIX, D, PART, 4};
          pg8::gemm_phase(lds, D, D, S, E); }
        GSYNC();
        PH(0) { PHASE_BEGIN
          const float* nw = PIN(I_NORMW) + (size_t)l * 4 * D;
          phase_norm(P, l == 0 ? 3 : 1, MIX, nw + D, nw + 2 * D, HB, XSB, PART, 4); }
        for (int rep_ = 0; rep_ < ((PROBE_DUP & 32) ? 2 : 1); ++rep_) PH(1) { PHASE_BEGIN
            const int tid = opaque_tid(), lane = tid & 63, wave = __builtin_amdgcn_readfirstlane(tid >> 6); const int gw = c * 8 + wave, NGW = (G + z) * 8;
            const float* wf1 = PIN(I_WF1) + (size_t)l * D * 2 * DFF; const float* wf2 = PIN(I_WF2) + (size_t)l * DFF * D;
            const int n1 = 32 * 44, n2 = 88 * 8;
            { const int tot4 = (n1 + n2) * 4; const int s0 = (int)((unsigned)(gw * tot4) / (unsigned)NGW), s1 = (int)((unsigned)((gw + 1) * tot4) / (unsigned)NGW);
            for (int ss = s0; ss < s1; ++ss) {
                const int it = ss >> 2, sub = ss & 3;
                if (it < n1) transpose_item<1>(wf1, D, 2 * DFF, WF1, it, sub, lane);
                else transpose_item<0>(wf2, DFF, D, WF2, it - n1, sub, lane);
            } }
        }
        GSYNC();
        PH(12) { PHASE_BEGIN
          pg8::DenseOrder S{HB, WF1, D, D, MP / 256, 44, G, c, D / 64}; pg8::EpiSwiglu E{HID};
#if PROBE_DUP & 256
          pg8::gemm_phase(lds, D, D, S, E);
#endif
          pg8::gemm_phase(lds, D, D, S, E); }
        GSYNC();
        PH(11) { PHASE_BEGIN
          pg8::SplitOrder S{HID, WF2, DFF, DFF, MP / 256, 8, G, c, DFF / 64, 11, 8}; pg8::EpiMix E{FFO, D, PART, 11};
#if PROBE_DUP & 8
          pg8::gemm_phase(lds, DFF, DFF, S, E);
#endif
          pg8::gemm_phase(lds, DFF, DFF, S, E); }
        GSYNC();
    }
    PH(0) { PHASE_BEGIN
      phase_norm(P, 2, FFO, PIN(I_NORMW) + (size_t)(4 + 3) * D, nullptr, HB, XSB, PART, 11); }
}

extern "C" void kernel_launch(void* const* d_in, const int* in_sizes, int n_in, void* d_out, int out_size, void* d_ws, size_t ws_size, hipStream_t stream) {
    static int grid_blocks = 0;
    if (!grid_blocks) {
        int dev = 0, cus = 0, per_cu = 0;
        hipGetDevice(&dev);
        hipDeviceGetAttribute(&cus, hipDeviceAttributeMultiprocessorCount, dev);
        hipFuncSetAttribute((const void*)mega_fwd, hipFuncAttributeMaxDynamicSharedMemorySize, LDS_BYTES);
        hipOccupancyMaxActiveBlocksPerMultiprocessor(&per_cu, (const void*)mega_fwd, 512, LDS_BYTES);
        if (per_cu < 1) per_cu = 1;
        grid_blocks = cus * per_cu;
        if (ws_size < WS_END) fprintf(stderr, "kernel_launch: workspace too small: %zu < %zu\n", ws_size, (size_t)WS_END);
    }
    Params p{};
    for (int i = 0; i < 29; ++i) p.in[i] = (const float*)d_in[i];
    p.out = (float*)d_out; p.ws = (unsigned char*)d_ws;
    void* args[] = {&p};
    hipError_t e = hipLaunchCooperativeKernel((const void*)mega_fwd, dim3(grid_blocks), dim3(512), args, LDS_BYTES, stream);
    if (e != hipSuccess) fprintf(stderr, "cooperative launch failed: %s (grid %d)\n", hipGetErrorString(e), grid_blocks);
}
```
